# Optimizing an MI355X kernel written in HIP

```python
import math
import jax, jax.numpy as jnp
from jax import lax
import numpy as np

D_MODEL = 1024
BATCH = 4
SEQ = 8192
DEPTH = 1

CHUNK = 64
N_HEADS_A = 4
HEAD_DIM_A = 64
WIDTH_A = N_HEADS_A * 2 * HEAD_DIM_A
Q_BLOCK = 128
N_HEADS_B = 8
HEAD_DIM_B = 64
WIDTH_B = N_HEADS_B * HEAD_DIM_B
N_PREV_CHUNKS = 8
REL_CLIP = 128
IN_COLS = 3 * WIDTH_A + 3 * WIDTH_B + 2 * D_MODEL
N_EXPERTS = 32
TOP_K = 4
D_FF = 1024
SWIGLU_ALPHA = 1.702
SWIGLU_LIMIT = 7.0
EXPERT_BLOCK = 128
DEEPNORM_ALPHA = (2 * DEPTH) ** 0.25
DEEPNORM_BETA = (8 * DEPTH) ** -0.25
LN_EPS = 1e-5

kernel_name = "hybrid_diffattn_chunkband_moe_deepnorm"


def layer_norm(x, g, b):
    xf = x.astype(jnp.float32)
    mu = jnp.mean(xf, axis=-1, keepdims=True)
    var = jnp.mean(jnp.square(xf - mu), axis=-1, keepdims=True)
    y = (xf - mu) * lax.rsqrt(var + LN_EPS) * g.astype(jnp.float32) + b.astype(jnp.float32)
    return y.astype(x.dtype)


def rms_norm(x, w):
    xf = x.astype(jnp.float32)
    y = xf * lax.rsqrt(jnp.mean(jnp.square(xf), axis=-1, keepdims=True) + LN_EPS) * w.astype(jnp.float32)
    return y.astype(x.dtype)


def alibi_slopes(n):
    return jnp.asarray(np.array([2.0 ** (-8.0 * (i + 1) / n) for i in range(n)], dtype=np.float32))


def diff_attention(q, k, v, lam, lam_init, subln_w):
    B, S = q.shape[0], q.shape[1]
    scale = HEAD_DIM_A ** -0.5
    q = q.transpose(0, 2, 1, 3, 4) * scale
    k = k.transpose(0, 2, 1, 3, 4)
    v = v.transpose(0, 2, 1, 3)
    n_qb = S // Q_BLOCK
    qb = q.reshape(B, N_HEADS_A, n_qb, Q_BLOCK, 2, HEAD_DIM_A).transpose(2, 0, 1, 3, 4, 5)
    kpos = jnp.arange(S, dtype=jnp.int32)
    kchunk = kpos // CHUNK
    slopes = alibi_slopes(N_HEADS_A)

    def one_block(args):
        q_blk, i = args
        qpos = i * Q_BLOCK + jnp.arange(Q_BLOCK, dtype=jnp.int32)
        s = jnp.einsum('bhqcd,bhkcd->cbhqk', q_blk, k).astype(jnp.float32)
        dist = jnp.abs(qpos[:, None] - kpos[None, :]).astype(jnp.float32)
        bias = -slopes[:, None, None] * dist
        allowed = kchunk[None, :] <= (qpos // CHUNK)[:, None]
        p = jax.nn.softmax(jnp.where(allowed, s + bias, -jnp.inf), axis=-1)
        a = p[0] - lam * p[1]
        return jnp.einsum('bhqk,bhkd->bhqd', a.astype(v.dtype), v)

    o = lax.map(one_block, (qb, jnp.arange(n_qb, dtype=jnp.int32)))
    o = o.transpose(1, 0, 3, 2, 4).reshape(B, S, N_HEADS_A, 2 * HEAD_DIM_A)
    o = rms_norm(o, subln_w) * (1.0 - lam_init)
    return o.reshape(B, S, WIDTH_A)


def chunk_band_attention(q, k, v, rel_bias):
    B, S = q.shape[0], q.shape[1]
    n_chunks = S // CHUNK
    pad_len = N_PREV_CHUNKS * CHUNK
    band = (N_PREV_CHUNKS + 1) * CHUNK
    scale = HEAD_DIM_B ** -0.5
    q = q.transpose(0, 2, 1, 3) * scale
    kp = jnp.pad(k.transpose(0, 2, 1, 3), ((0, 0), (0, 0), (pad_len, 0), (0, 0)))
    vp = jnp.pad(v.transpose(0, 2, 1, 3), ((0, 0), (0, 0), (pad_len, 0), (0, 0)))
    qc = q.reshape(B, N_HEADS_B, n_chunks, CHUNK, HEAD_DIM_B).transpose(2, 0, 1, 3, 4)
    qi = jnp.arange(CHUNK, dtype=jnp.int32)
    kj = jnp.arange(band, dtype=jnp.int32)
    rel = (kj[None, :] - pad_len) - qi[:, None]
    bias = rel_bias.astype(jnp.float32)[:, jnp.clip(rel, -REL_CLIP, REL_CLIP) + REL_CLIP]

    def one_chunk(args):
        q_blk, c = args
        start = c * CHUNK
        kb = lax.dynamic_slice_in_dim(kp, start, band, axis=2)
        vb = lax.dynamic_slice_in_dim(vp, start, band, axis=2)
        s = jnp.einsum('bhqd,bhkd->bhqk', q_blk, kb).astype(jnp.float32) + bias
        valid = (start - pad_len + kj) >= 0
        p = jax.nn.softmax(jnp.where(valid, s, -jnp.inf), axis=-1)
        return jnp.einsum('bhqk,bhkd->bhqd', p.astype(vb.dtype), vb)

    o = lax.map(one_chunk, (qc, jnp.arange(n_chunks, dtype=jnp.int32)))
    return o.transpose(1, 0, 3, 2, 4).reshape(B, S, WIDTH_B)


def gated_mixer(h, w_in, b_gate, lam_q1, lam_k1, lam_q2, lam_k2, subln_w, rel_bias,
                w_branch_a, w_branch_b, w_out, lam_init):
    B, S, D = h.shape
    proj = h @ w_in
    o0 = 0
    qa = proj[..., o0:o0 + WIDTH_A].reshape(B, S, N_HEADS_A, 2, HEAD_DIM_A); o0 += WIDTH_A
    ka = proj[..., o0:o0 + WIDTH_A].reshape(B, S, N_HEADS_A, 2, HEAD_DIM_A); o0 += WIDTH_A
    va = proj[..., o0:o0 + WIDTH_A].reshape(B, S, N_HEADS_A, 2 * HEAD_DIM_A); o0 += WIDTH_A
    qb = proj[..., o0:o0 + WIDTH_B].reshape(B, S, N_HEADS_B, HEAD_DIM_B); o0 += WIDTH_B
    kb = proj[..., o0:o0 + WIDTH_B].reshape(B, S, N_HEADS_B, HEAD_DIM_B); o0 += WIDTH_B
    vb = proj[..., o0:o0 + WIDTH_B].reshape(B, S, N_HEADS_B, HEAD_DIM_B); o0 += WIDTH_B
    gates = jax.nn.sigmoid(proj[..., o0:] + b_gate).reshape(B, S, 2, D)

    lam = (jnp.exp(jnp.sum(lam_q1.astype(jnp.float32) * lam_k1.astype(jnp.float32)))
           - jnp.exp(jnp.sum(lam_q2.astype(jnp.float32) * lam_k2.astype(jnp.float32))) + lam_init)
    out_a = diff_attention(qa, ka, va, lam, lam_init, subln_w)
    out_b = chunk_band_attention(qb, kb, vb, rel_bias)
    merged = gates[:, :, 0] * (out_a @ w_branch_a) + gates[:, :, 1] * (out_b @ w_branch_b)
    return merged @ w_out


def moe_ffn(h, w_router, b_router, w_exp_in, b_exp_in, w_exp_out, b_exp_out):
    B, S, D = h.shape
    t = h.reshape(-1, D)
    n_tok = t.shape[0]
    logits = (t @ w_router + b_router).astype(jnp.float32)
    top_val, top_idx = lax.top_k(logits, TOP_K)
    gate_w = jax.nn.softmax(top_val, axis=-1).astype(h.dtype)

    n_slots = n_tok * TOP_K
    e_flat = top_idx.reshape(-1).astype(jnp.int32)
    tok_flat = jnp.arange(n_slots, dtype=jnp.int32) // TOP_K
    order = jnp.argsort(e_flat)
    e_sorted = e_flat[order]
    counts = jnp.bincount(e_flat, length=N_EXPERTS).astype(jnp.int32)
    padded = (counts + EXPERT_BLOCK - 1) // EXPERT_BLOCK * EXPERT_BLOCK
    start = jnp.cumsum(counts) - counts
    pend = jnp.cumsum(padded)
    pstart = pend - padded
    rank = jnp.arange(n_slots, dtype=jnp.int32) - start[e_sorted]
    dest_sorted = pstart[e_sorted] + rank
    buf_len = (-(-n_slots // EXPERT_BLOCK)) * EXPERT_BLOCK + N_EXPERTS * EXPERT_BLOCK
    n_blocks = buf_len // EXPERT_BLOCK
    buf_tok = jnp.full((buf_len,), n_tok, jnp.int32).at[dest_sorted].set(tok_flat[order])
    dest = jnp.zeros((n_slots,), jnp.int32).at[order].set(dest_sorted)
    block_start = jnp.arange(n_blocks, dtype=jnp.int32) * EXPERT_BLOCK
    block_exp = jnp.minimum(jnp.searchsorted(pend, block_start, side='right'), N_EXPERTS - 1).astype(jnp.int32)
    t_pad = jnp.concatenate([t, jnp.zeros((1, D), t.dtype)], axis=0)

    def expert_block(args):
        tok_idx, e = args
        xb = t_pad[tok_idx]
        hb = xb @ w_exp_in[e] + b_exp_in[e]
        g = jnp.minimum(hb[:, :D_FF], SWIGLU_LIMIT)
        u = jnp.clip(hb[:, D_FF:], -SWIGLU_LIMIT, SWIGLU_LIMIT)
        a = g * jax.nn.sigmoid(SWIGLU_ALPHA * g) * (u + 1.0)
        return a @ w_exp_out[e] + b_exp_out[e]

    y_buf = lax.map(expert_block, (buf_tok.reshape(n_blocks, EXPERT_BLOCK), block_exp)).reshape(buf_len, D)
    y_slot = y_buf[dest].reshape(n_tok, TOP_K, D)
    y = jnp.einsum('nk,nkd->nd', gate_w, y_slot)
    return y.reshape(B, S, D)


def setup_inputs(seed: int = 0) -> dict:
    key = jax.random.key(seed)
    ks = jax.random.split(key, 24)
    L, D, E, F = DEPTH, D_MODEL, N_EXPERTS, D_FF
    nrm = lambda k, shape: jax.random.normal(k, shape, jnp.float32)
    col_scale = np.ones((IN_COLS,), np.float32)
    col_scale[2 * WIDTH_A:3 * WIDTH_A] = DEEPNORM_BETA
    col_scale[3 * WIDTH_A + 2 * WIDTH_B:3 * WIDTH_A + 3 * WIDTH_B] = DEEPNORM_BETA
    return {
        "x": nrm(ks[0], (BATCH, SEQ, D)),
        "ln_in_g": 1.0 + 0.05 * nrm(ks[1], (D,)),
        "ln_in_b": 0.02 * nrm(ks[2], (D,)),
        "w_in": nrm(ks[3], (L, D, IN_COLS)) * (D ** -0.5) * jnp.asarray(col_scale),
        "b_gate": 0.02 * nrm(ks[4], (L, 2 * D)),
        "lambda_q1": 0.1 * nrm(ks[5], (L, HEAD_DIM_A)),
        "lambda_k1": 0.1 * nrm(ks[6], (L, HEAD_DIM_A)),
        "lambda_q2": 0.1 * nrm(ks[7], (L, HEAD_DIM_A)),
        "lambda_k2": 0.1 * nrm(ks[8], (L, HEAD_DIM_A)),
        "subln_w": 1.0 + 0.05 * nrm(ks[9], (L, 2 * HEAD_DIM_A)),
        "rel_bias": 0.1 * nrm(ks[10], (L, N_HEADS_B, 2 * REL_CLIP + 1)),
        "w_branch_a": nrm(ks[11], (L, WIDTH_A, D)) * (WIDTH_A ** -0.5) * DEEPNORM_BETA,
        "w_branch_b": nrm(ks[12], (L, WIDTH_B, D)) * (WIDTH_B ** -0.5) * DEEPNORM_BETA,
        "w_out": nrm(ks[13], (L, D, D)) * (D ** -0.5) * DEEPNORM_BETA,
        "ln1_g": 1.0 + 0.05 * nrm(ks[14], (L, D)),
        "ln1_b": 0.02 * nrm(ks[15], (L, D)),
        "w_router": nrm(ks[16], (L, D, E)) * (D ** -0.5),
        "b_router": 0.01 * nrm(ks[17], (L, E)),
        "w_exp_in": nrm(ks[18], (L, E, D, 2 * F)) * (D ** -0.5) * DEEPNORM_BETA,
        "b_exp_in": 0.01 * nrm(ks[19], (L, E, 2 * F)),
        "w_exp_out": nrm(ks[20], (L, E, F, D)) * (F ** -0.5) * DEEPNORM_BETA,
        "b_exp_out": 0.01 * nrm(ks[21], (L, E, D)),
        "ln2_g": 1.0 + 0.05 * nrm(ks[22], (L, D)),
        "ln2_b": 0.02 * nrm(ks[23], (L, D)),
    }


def reference(x, ln_in_g, ln_in_b, w_in, b_gate, lambda_q1, lambda_k1, lambda_q2, lambda_k2,
              subln_w, rel_bias, w_branch_a, w_branch_b, w_out, ln1_g, ln1_b,
              w_router, b_router, w_exp_in, b_exp_in, w_exp_out, b_exp_out, ln2_g, ln2_b):
    h = layer_norm(x, ln_in_g, ln_in_b)
    for l in range(DEPTH):
        lam_init = 0.8 - 0.6 * math.exp(-0.3 * l)
        m = gated_mixer(h, w_in[l], b_gate[l], lambda_q1[l], lambda_k1[l], lambda_q2[l], lambda_k2[l],
                        subln_w[l], rel_bias[l], w_branch_a[l], w_branch_b[l], w_out[l], lam_init)
        h = layer_norm(DEEPNORM_ALPHA * h + m, ln1_g[l], ln1_b[l])
        f = moe_ffn(h, w_router[l], b_router[l], w_exp_in[l], b_exp_in[l], w_exp_out[l], b_exp_out[l])
        h = layer_norm(DEEPNORM_ALPHA * h + f, ln2_g[l], ln2_b[l])
    return h
```

```cpp
#include <hip/hip_runtime.h>
#include <cstdint>
#include <cstdio>

typedef unsigned short bf16_t;
#ifndef ATT_SPLIT_QB
#define ATT_SPLIT_QB 32
#endif
#ifndef PROBE_PH
#define PROBE_PH -1
#endif

constexpr int NB = 4, SEQ = 8192, D = 1024, NTOK = NB * SEQ, INC = 5120;
constexpr int NE = 32, TOPK = 4, DFF = 1024;
constexpr int LCAP = NTOK;
constexpr int MAXT = NTOK * TOPK / 256 + NE;
constexpr float ALPHA = 1.189207115002721f;
constexpr float LN_EPS = 1e-5f;
constexpr float LOG2E = 1.4426950408889634f;
constexpr float C2 = 0.125f * LOG2E;
constexpr float LAM_INIT = 0.2f;
constexpr float SWA = 1.702f, SWL = 7.0f;

constexpr size_t MiB = 1u << 20;
constexpr size_t WS_CTL = 0;
constexpr size_t WS_TOPI = 1 * MiB;
constexpr size_t WS_TOPW = 2 * MiB;
constexpr size_t WS_LIST = 3 * MiB;
constexpr size_t WS_ST0 = 7 * MiB;
constexpr size_t WS_ST1 = 7 * MiB + 256 * 1024;
constexpr size_t WS_TINFO = 7 * MiB + 512 * 1024;
constexpr size_t WS_WIN = 8 * MiB;
constexpr size_t WS_WA = 18 * MiB, WS_WB = 19 * MiB, WS_WOUT = 20 * MiB;
constexpr size_t WS_WEI = 32 * MiB;
constexpr size_t WS_WEO = 160 * MiB;
constexpr size_t WS_XN = 224 * MiB;
constexpr size_t WS_PROJ = 288 * MiB;
constexpr size_t WS_OUTAB = 608 * MiB;
constexpr size_t WS_MERGED = 672 * MiB;
constexpr size_t WS_SLOT = 736 * MiB;
constexpr size_t WS_GATES = 800 * MiB;
constexpr size_t WS_END = 992 * MiB;
constexpr int CW_CNT = 64;
constexpr int CW_Q = 128;
constexpr int CW_CQ = 704;
constexpr int CW_NRM = 8192;
constexpr int CW_AC = 1024;

__device__ __forceinline__ float bf2f(unsigned v) { return __uint_as_float(v << 16); }
__device__ __forceinline__ unsigned f2bf(float f) { unsigned u = __float_as_uint(f); return (u + 0x7fffu + ((u >> 16) & 1u)) >> 16; }
__device__ __forceinline__ float wave_sum(float v) {
#pragma unroll
    for (int o = 1; o < 64; o <<= 1) v += __shfl_xor(v, o);
    return v;
}
__device__ __forceinline__ float wave_max(float v) {
#pragma unroll
    for (int o = 1; o < 64; o <<= 1) v = fmaxf(v, __shfl_xor(v, o));
    return v;
}

#define LAS __attribute__((address_space(3)))
#define GAS __attribute__((address_space(1)))
typedef short bf16x8 __attribute__((ext_vector_type(8)));
typedef float f32x4 __attribute__((ext_vector_type(4)));
typedef float f32x2 __attribute__((ext_vector_type(2)));
typedef unsigned u32x4 __attribute__((ext_vector_type(4)));
typedef unsigned u32x2 __attribute__((ext_vector_type(2)));
#define GAS __attribute__((address_space(1)))
#define GST(T, p) (*(GAS T*)(p))
#define GLD(T, p) (*(const GAS T*)(p))
typedef int v8i32_t __attribute__((ext_vector_type(8)));
typedef int v4i32_t __attribute__((ext_vector_type(4)));
typedef GAS unsigned gu32;

namespace pg {
constexpr int BM = 256, BK = 64, HALF = 128, HTB = HALF * BK * 2, STAGE_BYTES = 8 * HTB, NXCD = 8, WGM = 8;
__host__ __device__ __forceinline__ int lds_byte(int r, int c) { const int st = (r >> 4) * 2 + (c >> 5), rr = r & 15, cc = c & 31, ob = rr * 64 + cc * 2; return st * 1024 + (ob ^ (((ob >> 9) & 1) << 5)); }
__host__ __device__ __forceinline__ void stage_rc(int b, int& R, int& C) { const int st = b / 1024, sb = b % 1024, swz = sb ^ (((sb >> 9) & 1) << 5); R = (st >> 1) * 16 + swz / 64; C = (st & 1) * 32 + (swz % 64) / 2; }
__host__ __device__ __forceinline__ int perm32(int rho) { const int n = rho >> 4, i = rho & 15; return 8 * (i >> 2) + 4 * n + (i & 3); }
__device__ __forceinline__ unsigned cvt_pk_bf16(float lo, float hi) { unsigned r; asm volatile("v_cvt_pk_bf16_f32 %0, %1, %2" : "=v"(r) : "v"(lo), "v"(hi)); return r; }

struct Unit { const char* A; const char* B; int pm, pn, x0, x1, x2, x3; };

struct GridOrder {
    int nM, nN, nwg, G, c;
    __device__ void init(int nM_, int nN_, int G_, int c_) { nM = nM_; nN = nN_; nwg = nM * nN; G = G_; c = c_; }
    __device__ bool tile(int i, int& pm, int& pn) const {
        const long L = (long)i * G + c; if (L >= nwg) return false;
        int wgid = (int)L; { const int q = nwg / NXCD, r = nwg % NXCD, xcd = wgid % NXCD, off = wgid / NXCD; wgid = (xcd < r ? xcd * (q + 1) : r * (q + 1) + (xcd - r) * q) + off; }
        const int nig = WGM * nN, gid = wgid / nig, fm = gid * WGM, gsz = (nM - fm) < WGM ? (nM - fm) : WGM;
        pm = fm + ((wgid % nig) % gsz); pn = (wgid % nig) / gsz; return true;
    }
};

template <class Epi, class Sched, bool GATHER, bool F8 = false>
__device__ __forceinline__ void gemm_phase(LAS unsigned char* lds, LAS unsigned* tok_tab, const int* list, const int K, const unsigned lda, const unsigned ldb, const Sched& S, const Epi& E) {
    const int tid = threadIdx.x, wid = __builtin_amdgcn_readfirstlane(tid >> 6), lane = tid & 63, wr = wid >> 2, wc = wid & 3, fr = lane & 15, fq = lane >> 4;
    const int nt = K / BK;
    unsigned voffA[2], voffB[2]; int R0g = 0; unsigned C2g = 0;
#pragma unroll
    for (int i = 0; i < 2; ++i) { int R, C; stage_rc(tid * 16 + i * 8192, R, C); const int Rb = Epi::PERM ? ((R & ~31) + perm32(R & 31)) : R;
        voffA[i] = (unsigned)R * lda + (unsigned)C * 2u; voffB[i] = (unsigned)Rb * ldb + (unsigned)C * 2u; if (i == 0) { R0g = R; C2g = (unsigned)C * 2u; } }
#define PG_TOKDMA(slot, lidx) do { if (wid == 0) __builtin_amdgcn_global_load_lds((const unsigned*)(list + (lidx) + lane * 4), (LAS unsigned*)(tok_tab + (slot) * 256), 16, 0, 0); } while (0)
#define PG_STAGE_G(bufoff, gbase, slot, h) do { const LAS unsigned* _t = tok_tab + (slot) * 256 + (h) * 128 + R0g; const unsigned _t0 = _t[0] >> 2, _t1 = _t[64] >> 2; \
        __builtin_amdgcn_global_load_lds((const unsigned*)((const char*)(gbase) + _t0 * lda + C2g), (LAS unsigned*)(lds + (bufoff) + ldsw), 16, 0, 0); \
        __builtin_amdgcn_global_load_lds((const unsigned*)((const char*)(gbase) + _t1 * lda + C2g), (LAS unsigned*)(lds + (bufoff) + ldsw + 8192), 16, 0, 0); } while (0)
    unsigned goff[2][2] = {{0u, 0u}, {0u, 0u}};
#define PG_GOFF(slot) do { _Pragma("unroll") for (int h_ = 0; h_ < 2; ++h_) { const LAS unsigned* _t = tok_tab + (slot) * 256 + h_ * 128 + R0g; goff[h_][0] = (_t[0] >> 2) * lda + C2g; goff[h_][1] = (_t[64] >> 2) * lda + C2g; } } while (0)
#define PG_STAGE_GR(bufoff, gbase, h) do { \
        __builtin_amdgcn_global_load_lds((const unsigned*)((const char*)(gbase) + goff[h][0]), (LAS unsigned*)(lds + (bufoff) + ldsw), 16, 0, 0); \
        __builtin_amdgcn_global_load_lds((const unsigned*)((const char*)(gbase) + goff[h][1]), (LAS unsigned*)(lds + (bufoff) + ldsw + 8192), 16, 0, 0); } while (0)
#define PG_STAGE_A(bufoff, gbase, h, slot) do { if constexpr (GATHER) { if ((slot) == (ui & 1)) PG_STAGE_GR(bufoff, gbase, h); else PG_STAGE_G(bufoff, gbase, slot, h); } else { PG_STAGE(bufoff, (gbase) + (h) * hstepA, voffA); } } while (0)
    const size_t kstep = (size_t)(BK * 2);
    const size_t hstepA = (size_t)HALF * lda, hstepB = (size_t)HALF * ldb;
    const unsigned ldsw = (unsigned)wid * 1024u;
    const int aoff = lds_byte(wr * 64 + fr, fq * 8);
    const int boff = lds_byte(wc * 32 + fr, fq * 8);
    constexpr int KOFF = 1024;
#define PG_SA(b, h) (((b) * 2 + (h)) * HTB)
#define PG_SB(b, h) ((4 + (b) * 2 + (h)) * HTB)
#define PG_STAGE(bufoff, gbase, voff) do { _Pragma("unroll") for (int _i = 0; _i < 2; ++_i) \
        __builtin_amdgcn_global_load_lds((const unsigned*)((const char*)(gbase) + (voff)[_i]), (LAS unsigned*)(lds + (bufoff) + ldsw + _i * 8192), 16, 0, 0); } while (0)
#define PG_LDA(dst, b, h) do { _Pragma("unroll") for (int m = 0; m < 4; ++m) _Pragma("unroll") for (int k = 0; k < 2; ++k) dst[m][k] = *(const LAS bf16x8*)(lds + PG_SA(b, h) + aoff + m * 2048 + k * KOFF); } while (0)
#define PG_LDB(dst, b, h) do { _Pragma("unroll") for (int n = 0; n < 2; ++n) _Pragma("unroll") for (int k = 0; k < 2; ++k) dst[n][k] = *(const LAS bf16x8*)(lds + PG_SB(b, h) + boff + n * 2048 + k * KOFF); } while (0)
#define PG_RD8(p_) __builtin_shufflevector(*(const LAS v4i32_t*)(p_), *(const LAS v4i32_t*)((p_) + KOFF), 0, 1, 2, 3, 4, 5, 6, 7)
#define PG_LDA8(dst, b, h) do { _Pragma("unroll") for (int m = 0; m < 4; ++m) dst[m] = PG_RD8(lds + PG_SA(b, h) + aoff + m * 2048); } while (0)
#define PG_LDB8(dst, b, h) do { _Pragma("unroll") for (int n = 0; n < 2; ++n) dst[n] = PG_RD8(lds + PG_SB(b, h) + boff + n * 2048); } while (0)
#define PG_MMA8(ai, bj, At, Bt) do { __builtin_amdgcn_s_setprio(1); _Pragma("unroll") for (int m = 0; m < 4; ++m) _Pragma("unroll") for (int n = 0; n < 2; ++n) \
        asm volatile("v_mfma_scale_f32_16x16x128_f8f6f4 %0, %1, %2, %0, %3, %3 op_sel_hi:[0,0,0]" : "+v"(acc[ai][bj][m][n]) : "v"(Bt[n]), "v"(At[m]), "v"(sc8)); __builtin_amdgcn_s_setprio(0); } while (0)
#define PG_MMA(ai, bj, At, Bt) do { __builtin_amdgcn_s_setprio(1); _Pragma("unroll") for (int m = 0; m < 4; ++m) _Pragma("unroll") for (int n = 0; n < 2; ++n) _Pragma("unroll") for (int k = 0; k < 2; ++k) \
        acc[ai][bj][m][n] = __builtin_amdgcn_mfma_f32_16x16x32_bf16(Bt[n][k], At[m][k], acc[ai][bj][m][n], 0, 0, 0); __builtin_amdgcn_s_setprio(0); } while (0)
#define PG_WAIT_V(n) asm volatile("s_waitcnt vmcnt(" #n ")" ::: "memory")
#define PG_WAIT_L(n) asm volatile("s_waitcnt lgkmcnt(" #n ")" ::: "memory")
#define PG_BAR __builtin_amdgcn_s_barrier()
#define PG_SCHED __builtin_amdgcn_sched_barrier(0)
    Unit cur, nxt; int ui = 0;
    if (!S.next(0, cur)) return;
    f32x4 acc[2][2][4][2];
#pragma unroll
    for (int a = 0; a < 2; ++a)
#pragma unroll
        for (int b = 0; b < 2; ++b)
#pragma unroll
            for (int m = 0; m < 4; ++m)
#pragma unroll
                for (int n = 0; n < 2; ++n) acc[a][b][m][n] = (f32x4){0.f, 0.f, 0.f, 0.f};
    bf16x8 At[4][2], B0[2][2], B1[2][2]; v8i32_t At8[4], B08[2], B18[2];
    const int sc8 = 0x7F7F7F7F;
    const char* cA = cur.A; const char* cB = cur.B;
    if constexpr (GATHER) { PG_TOKDMA(0, cur.x3); PG_WAIT_V(0); PG_BAR; PG_GOFF(0); }
#define PG_ROWDMA(slot, lidx) do { if (wid == 0) { __builtin_amdgcn_global_load_lds((const unsigned*)(list + (lidx) + lane * 4), (LAS unsigned*)(tok_tab + (slot) * 256), 16, 0, 0); \
        __builtin_amdgcn_global_load_lds((const unsigned*)(E.listw + (lidx) + lane * 4), (LAS unsigned*)(tok_tab + 512 + (slot) * 256), 16, 0, 0); } } while (0)
    if constexpr (Epi::ROWINFO) { PG_ROWDMA(0, cur.x3); }
#define PG_BIASDMA(slot, un) do { if (wid == 0) __builtin_amdgcn_global_load_lds((const unsigned*)E.bias_src(un, lane), (LAS unsigned*)(tok_tab + 1024 + (slot) * 256), 16, 0, 0); } while (0)
    if constexpr (Epi::BIASLDS) { PG_BIASDMA(0, cur); }
    PG_STAGE(PG_SB(0, 0), cB, voffB); PG_STAGE(PG_SB(0, 1), cB + hstepB, voffB); PG_STAGE_A(PG_SA(0, 0), cA, 0, 0); PG_STAGE_A(PG_SA(0, 1), cA, 1, 0);
    if (wr == 1) PG_BAR;
    PG_WAIT_V(2); PG_BAR;
    PG_STAGE(PG_SB(1, 0), cB + kstep, voffB); PG_STAGE_A(PG_SA(1, 0), cA + kstep, 0, 0); PG_STAGE(PG_SB(1, 1), cB + hstepB + kstep, voffB);
    PG_WAIT_V(6); PG_BAR;
    for (;;) {
        const bool has_next = S.next(ui + 1, nxt);
        const char* nA = has_next ? nxt.A : cA; const char* nB = has_next ? nxt.B : cB;
        if constexpr (GATHER) { if (has_next) PG_TOKDMA((ui + 1) & 1, nxt.x3); }
        if constexpr (Epi::ROWINFO) { if (ui > 0) PG_ROWDMA(ui & 1, cur.x3); }
        if constexpr (Epi::BIASLDS) { if (ui > 0) PG_BIASDMA(ui & 1, cur); }
#pragma unroll 1
        for (int t = 0; t < nt; t += 2) {
            const bool last = (t == nt - 2);
            const char* a1 = cA + (size_t)(t + 1) * kstep;
            const char* a2 = last ? nA : cA + (size_t)(t + 2) * kstep; const char* b2 = last ? nB : cB + (size_t)(t + 2) * kstep;
            const char* a3 = a2 + kstep; const char* b3 = b2 + kstep;
            const int sc_ = ui & 1, sn_ = (last && has_next) ? ((ui + 1) & 1) : (ui & 1);
            if constexpr (F8) {
            PG_LDB8(B08, 0, 0); PG_LDB8(B18, 0, 1); PG_SCHED; PG_LDA8(At8, 0, 0); PG_STAGE_A(PG_SA(1, 1), a1, 1, sc_);
            PG_WAIT_V(8); PG_WAIT_L(0); PG_BAR; PG_MMA8(0, 0, At8, B08); PG_MMA8(0, 1, At8, B18); PG_BAR; PG_SCHED;
            PG_LDA8(At8, 0, 1); PG_STAGE(PG_SB(0, 0), b2, voffB); PG_STAGE(PG_SB(0, 1), b2 + hstepB, voffB); PG_STAGE_A(PG_SA(0, 0), a2, 0, sn_);
            PG_WAIT_V(8); PG_WAIT_L(0); PG_BAR; PG_MMA8(1, 0, At8, B08); PG_MMA8(1, 1, At8, B18); PG_BAR; PG_SCHED;
            PG_LDB8(B08, 1, 0); PG_LDB8(B18, 1, 1); PG_SCHED; PG_LDA8(At8, 1, 0); PG_STAGE_A(PG_SA(0, 1), a2, 1, sn_);
            PG_WAIT_V(8); PG_WAIT_L(0); PG_BAR; PG_MMA8(0, 0, At8, B08); PG_MMA8(0, 1, At8, B18); PG_BAR; PG_SCHED;
            PG_LDA8(At8, 1, 1); PG_STAGE(PG_SB(1, 0), b3, voffB); PG_STAGE(PG_SB(1, 1), b3 + hstepB, voffB); PG_STAGE_A(PG_SA(1, 0), a3, 0, sn_);
            PG_WAIT_V(8); PG_WAIT_L(0); PG_BAR; PG_MMA8(1, 0, At8, B08); PG_MMA8(1, 1, At8, B18); PG_BAR; PG_SCHED;
            } else {
            PG_LDB(B0, 0, 0); PG_LDB(B1, 0, 1); PG_SCHED; PG_LDA(At, 0, 0); PG_STAGE_A(PG_SA(1, 1), a1, 1, sc_);
            PG_WAIT_V(8); PG_WAIT_L(0); PG_BAR; PG_MMA(0, 0, At, B0); PG_MMA(0, 1, At, B1); PG_BAR; PG_SCHED;
            PG_LDA(At, 0, 1); PG_STAGE(PG_SB(0, 0), b2, voffB); PG_STAGE(PG_SB(0, 1), b2 + hstepB, voffB); PG_STAGE_A(PG_SA(0, 0), a2, 0, sn_);
            PG_WAIT_V(8); PG_WAIT_L(0); PG_BAR; PG_MMA(1, 0, At, B0); PG_MMA(1, 1, At, B1); PG_BAR; PG_SCHED;
            PG_LDB(B0, 1, 0); PG_LDB(B1, 1, 1); PG_SCHED; PG_LDA(At, 1, 0); PG_STAGE_A(PG_SA(0, 1), a2, 1, sn_);
            PG_WAIT_V(8); PG_WAIT_L(0); PG_BAR; PG_MMA(0, 0, At, B0); PG_MMA(0, 1, At, B1); PG_BAR; PG_SCHED;
            PG_LDA(At, 1, 1); PG_STAGE(PG_SB(1, 0), b3, voffB); PG_STAGE(PG_SB(1, 1), b3 + hstepB, voffB); PG_STAGE_A(PG_SA(1, 0), a3, 0, sn_);
            PG_WAIT_V(8); PG_WAIT_L(0); PG_BAR; PG_MMA(1, 0, At, B0); PG_MMA(1, 1, At, B1); PG_BAR; PG_SCHED;
            }
        }
        if (wr == 0) PG_BAR;
        if constexpr (F8) asm volatile("s_nop 15\n\ts_nop 15" ::: "memory");
        int le_ = threadIdx.x & 63; asm volatile("" : "+v"(le_));
        bool keep;
        if constexpr (Epi::ROWINFO) { keep = E(acc, cur, wr, wc, le_ & 15, le_ >> 4, tok_tab + (ui & 1) * 256, (const LAS float*)(tok_tab + 1024 + (ui & 1) * 256));
        }
        else if constexpr (Epi::BIASLDS) keep = E(acc, cur, wr, wc, le_ & 15, le_ >> 4, (const LAS float*)(tok_tab + 1024 + (ui & 1) * 256));
        else keep = E(acc, cur, wr, wc, le_ & 15, le_ >> 4);
        if (!has_next) break;
        if (!keep) {
#pragma unroll
        for (int a = 0; a < 2; ++a)
#pragma unroll
            for (int b = 0; b < 2; ++b)
#pragma unroll
                for (int m = 0; m < 4; ++m)
#pragma unroll
                    for (int n = 0; n < 2; ++n) acc[a][b][m][n] = (f32x4){0.f, 0.f, 0.f, 0.f};
        }
        cur = nxt; cA = nA; cB = nB; ++ui;
        if constexpr (GATHER) { PG_GOFF(ui & 1); }
        if (wr == 1) PG_BAR;
    }
    PG_WAIT_V(0);
    PG_BAR;
#undef PG_TOKDMA
#undef PG_ROWDMA
#undef PG_BIASDMA
#undef PG_STAGE_G
#undef PG_STAGE_GR
#undef PG_GOFF
#undef PG_STAGE_A
#undef PG_SA
#undef PG_SB
#undef PG_STAGE
#undef PG_LDA
#undef PG_LDB
#undef PG_MMA
#undef PG_MMA8
#undef PG_RD8
#undef PG_LDA8
#undef PG_LDB8
#undef PG_WAIT_V
#undef PG_WAIT_L
#undef PG_BAR
#undef PG_SCHED
}
}

namespace att {
typedef float f32x16 __attribute__((ext_vector_type(16)));
typedef short s16x4 __attribute__((ext_vector_type(4)));
typedef short v4i16_t __attribute__((ext_vector_type(4)));
typedef float f32x2_t __attribute__((ext_vector_type(2))); typedef __bf16 bf16x2_t __attribute__((ext_vector_type(2)));
__device__ __forceinline__ unsigned cvtpk(float lo, float hi) { f32x2_t v = {lo, hi}; bf16x2_t b = __builtin_convertvector(v, bf16x2_t); return __builtin_bit_cast(unsigned, b); }
__device__ __forceinline__ int crow(int r, int hi) { return (r & 3) + 8 * (r >> 2) + 4 * hi; }
constexpr int L_K = 0, L_V = 24576, L_WS = 90112, L_TAB = 92160, L_OST = 0;
constexpr float THR = 8.f;
__device__ __forceinline__ void glds16(const void* gsrc, unsigned lds_dst) { unsigned keep;
    asm volatile("s_mov_b32 %0, m0\n\ts_mov_b32 m0, %2\n\ts_nop 0\n\tglobal_load_lds_dwordx4 %1, off\n\ts_mov_b32 m0, %0" : "=&s"(keep) : "v"(gsrc), "s"(lds_dst) : "memory"); }
__device__ __forceinline__ float add1(float a, float b) { float r; asm("v_add_f32 %0, %1, %2" : "=v"(r) : "v"(a), "v"(b)); return r; }
__device__ __forceinline__ float adds1(float s, float b) { float r; asm("v_add_f32 %0, %1, %2" : "=v"(r) : "s"(s), "v"(b)); return r; }
__device__ __forceinline__ float max3f(float a, float b, float c) { float r; asm("v_max3_f32 %0, %1, %2, %3" : "=v"(r) : "v"(a), "v"(b), "v"(c)); return r; }
__device__ __forceinline__ s16x4 vtr(const LAS unsigned char* p) { return __builtin_bit_cast(s16x4, __builtin_amdgcn_ds_read_tr16_b64_v4i16((LAS v4i16_t*)p)); }

template <int DV, int MODE>
__device__ __forceinline__ void attn_pass(LAS unsigned char* lds, const bf16_t* proj, size_t rowb, int qcol, int kcol, int vcol, int q0, int tlo, int thi,
                                          float slope2, const LAS float* btab, float kmax, float bmax, f32x16 (&o)[DV / 32], float (&rli)[16]) {
    constexpr int NDB = DV / 32, VSLOT = 64 * DV * 2, NVP = DV / 64;
    const int tid = threadIdx.x, lane = tid & 63, r32 = lane & 31, hi = lane >> 5; const int wid = __builtin_amdgcn_readfirstlane(tid >> 6);
    const int qpos = q0 + 32 * wid + r32, myT = (q0 + 32 * wid) >> 6;
    const char* pjb = (const char*)proj + rowb * (size_t)(INC * 2);
    const unsigned qoff = (unsigned)(qpos * INC + qcol) * 2u;
    bf16x8 qr[4];
#pragma unroll
    for (int d0 = 0; d0 < 4; ++d0) qr[d0] = GLD(bf16x8, pjb + qoff + (d0 * 16 + hi * 8) * 2);
    const unsigned koff = (unsigned)(lane * INC + kcol + wid * 8) * 2u;
    unsigned voff[NVP];
#pragma unroll
    for (int j = 0; j < NVP; ++j) { const int pc = wid + 8 * j; voff[j] = (unsigned)((16 * (pc & 3) + (lane >> 2)) * INC + vcol + (pc >> 2) * 32 + (lane & 3) * 8) * 2u; }
    const unsigned ldsb = (unsigned)(uintptr_t)lds;
#define ATT_DMA(t, kslot, vslot) do { const char* tb_ = pjb + (size_t)(t) * (64 * INC * 2); \
      _Pragma("unroll") for (int rep_ = 0; rep_ < (PROBE_PH == 22 ? 2 : 1); ++rep_) { \
        glds16(tb_ + koff, (unsigned)__builtin_amdgcn_readfirstlane(ldsb + L_K + (kslot) * 8192 + wid * 1024)); \
        _Pragma("unroll") for (int _j = 0; _j < NVP; ++_j) \
            glds16(tb_ + voff[_j], (unsigned)__builtin_amdgcn_readfirstlane(ldsb + L_V + (vslot) * VSLOT + (wid + 8 * _j) * 1024)); } } while (0)
#define ATT_WAITBAR() do { asm volatile("s_waitcnt vmcnt(0) lgkmcnt(0)" ::: "memory"); __builtin_amdgcn_s_barrier(); asm volatile("" ::: "memory"); } while (0)
    const float s4hi = slope2 * (float)(4 * hi);
#define ATT_CR(r) ((float)(((r) & 3) + 8 * ((r) >> 2)))
    float mhat = 0.f, l = 0.f;
#pragma unroll
    for (int d = 0; d < NDB; ++d) o[d] = f32x16{};
    LAS float* wsf = (LAS float*)(lds + L_WS) + wid * 64;
    const LAS unsigned char* kfb = lds + L_K + hi * 1024 + r32 * 16;
    const LAS unsigned char* vfb = lds + L_V + ((lane >> 4) & 1) * 32 + (lane & 3) * 8 + (4 * hi + ((lane & 15) >> 2)) * 64;
    asm volatile("s_waitcnt lgkmcnt(0)" ::: "memory"); __builtin_amdgcn_s_barrier(); asm volatile("" ::: "memory");
    ATT_DMA(thi, 0, 0);
    if (thi > tlo) ATT_DMA(thi - 1, 1, 1);
    asm volatile("" : "+v"(qr[0]), "+v"(qr[1]), "+v"(qr[2]), "+v"(qr[3]));
    { float ss = 0.f;
#pragma unroll
      for (int d0 = 0; d0 < 4; ++d0)
#pragma unroll
          for (int j = 0; j < 8; ++j) { const float qv = __uint_as_float((unsigned)(unsigned short)qr[d0][j] << 16); ss = fmaf(qv, qv, ss); }
      auto rr = __builtin_amdgcn_permlane32_swap(__float_as_uint(ss), __float_as_uint(ss), false, false); ss = __uint_as_float(rr[0]) + __uint_as_float(rr[1]);
      mhat = sqrtf(ss) * 1.0002f * kmax + bmax; }
    ATT_WAITBAR();
    const bool grpB = (wid >= 4);
    bool pend = false; int pvs = 0;
    u32x4 pw[4];
    int ksl = 0, ksl2 = 2, vsl = 0, vsl2 = 2;
#define ATT_VF(v, ks) ((bf16x8){v[2 * (ks)][0], v[2 * (ks)][1], v[2 * (ks)][2], v[2 * (ks)][3], v[2 * (ks) + 1][0], v[2 * (ks) + 1][1], v[2 * (ks) + 1][2], v[2 * (ks) + 1][3]})
#define ATT_PV(vbase) do { const LAS unsigned char* vb_ = (vbase); s16x4 va[8], vc[8]; \
        _Pragma("unroll") for (int ks = 0; ks < 4; ++ks) { va[2 * ks] = vtr(vb_ + ks * 1024); va[2 * ks + 1] = vtr(vb_ + ks * 1024 + 512); } \
        _Pragma("unroll") for (int d0 = 0; d0 < NDB; d0 += 2) { \
            __builtin_amdgcn_sched_barrier(0); \
            _Pragma("unroll") for (int ks = 0; ks < 4; ++ks) { vc[2 * ks] = vtr(vb_ + (d0 + 1) * 4096 + ks * 1024); vc[2 * ks + 1] = vtr(vb_ + (d0 + 1) * 4096 + ks * 1024 + 512); } \
            _Pragma("unroll") for (int ks = 0; ks < 4; ++ks) o[d0] = __builtin_amdgcn_mfma_f32_32x32x16_bf16(__builtin_bit_cast(bf16x8, pw[ks]), ATT_VF(va, ks), o[d0], 0, 0, 0); \
            __builtin_amdgcn_sched_barrier(0); \
            if (d0 + 2 < NDB) { _Pragma("unroll") for (int ks = 0; ks < 4; ++ks) { va[2 * ks] = vtr(vb_ + (d0 + 2) * 4096 + ks * 1024); va[2 * ks + 1] = vtr(vb_ + (d0 + 2) * 4096 + ks * 1024 + 512); } } \
            _Pragma("unroll") for (int ks = 0; ks < 4; ++ks) o[d0 + 1] = __builtin_amdgcn_mfma_f32_32x32x16_bf16(__builtin_bit_cast(bf16x8, pw[ks]), ATT_VF(vc, ks), o[d0 + 1], 0, 0, 0); } } while (0)
    for (int t = thi; t >= tlo; --t) {
        const bool pre = (t - 2 >= tlo);
        if (pre) ATT_DMA(t - 2, ksl2, vsl2);
        if (grpB && pend) { ATT_PV(vfb + pvs * VSLOT); pend = false; __builtin_amdgcn_sched_barrier(0); }
        const int slot = ksl;
        const bool visible = (MODE == 0) ? (t <= myT) : (t <= myT && t >= myT - 8);
        if (visible) {
            f32x16 p0, p1;
            const LAS unsigned char* kb = kfb + slot * 8192;
            bf16x8 kf[8];
#pragma unroll
            for (int d0 = 0; d0 < 4; ++d0) { kf[2 * d0] = *(const LAS bf16x8*)(kb + d0 * 2048); kf[2 * d0 + 1] = *(const LAS bf16x8*)(kb + d0 * 2048 + 512); }
            __builtin_amdgcn_sched_barrier(0);
            if (MODE == 0) { const float base = s4hi - mhat - slope2 * (float)(qpos - 64 * t), base1 = base + 32.f * slope2;
                const float sj1 = slope2, sj2 = 2.f * slope2, sj3 = 3.f * slope2;
#pragma unroll
                for (int k = 0; k < 4; ++k) { const float b0 = fmaf(slope2, 8.f * (float)k, base), b1 = fmaf(slope2, 8.f * (float)k, base1);
                    p0[4 * k] = b0; p0[4 * k + 1] = adds1(sj1, b0); p0[4 * k + 2] = adds1(sj2, b0); p0[4 * k + 3] = adds1(sj3, b0);
                    p1[4 * k] = b1; p1[4 * k + 1] = adds1(sj1, b1); p1[4 * k + 2] = adds1(sj2, b1); p1[4 * k + 3] = adds1(sj3, b1); }
                asm volatile("s_nop 3" : "+v"(p0), "+v"(p1)); }
            else { const float base = (t <= myT - 3) ? (btab[0] - mhat) : -mhat;
#pragma unroll
                for (int r = 0; r < 16; ++r) { p0[r] = base; p1[r] = base; } }
#pragma unroll
            for (int d0 = 0; d0 < 4; ++d0) {
                p0 = __builtin_amdgcn_mfma_f32_32x32x16_bf16(kf[2 * d0], qr[d0], p0, 0, 0, 0); p1 = __builtin_amdgcn_mfma_f32_32x32x16_bf16(kf[2 * d0 + 1], qr[d0], p1, 0, 0, 0); }
            __builtin_amdgcn_sched_barrier(0);
            if (MODE == 0) { if (t == myT) { const float dq = s4hi - slope2 * (float)(qpos & 63), dq1 = dq + 32.f * slope2;
#pragma unroll
                for (int r = 0; r < 16; ++r) { p0[r] -= 2.f * fmaxf(fmaf(slope2, ATT_CR(r), dq), 0.f); p1[r] -= 2.f * fmaxf(fmaf(slope2, ATT_CR(r), dq1), 0.f); } } }
            else { if (t > myT - 3) { const int dbase = 64 * t - qpos + 4 * hi;
#pragma unroll
                for (int r = 0; r < 16; ++r) { const int d = dbase + (r & 3) + 8 * (r >> 2); const int i0 = min(max(d, -128), 128) + 128, i1 = min(max(d + 32, -128), 128) + 128; p0[r] += btab[i0]; p1[r] += btab[i1]; } } }
#pragma unroll
            for (int r = 0; r < 16; ++r) { p0[r] = __builtin_amdgcn_exp2f(p0[r]); p1[r] = __builtin_amdgcn_exp2f(p1[r]); }
#pragma unroll
            for (int r = 0; r < 16; ++r) { l += p0[r]; l += p1[r]; }
            pw[0] = (u32x4){cvtpk(p0[0], p0[1]), cvtpk(p0[2], p0[3]), cvtpk(p0[4], p0[5]), cvtpk(p0[6], p0[7])};
            pw[1] = (u32x4){cvtpk(p0[8], p0[9]), cvtpk(p0[10], p0[11]), cvtpk(p0[12], p0[13]), cvtpk(p0[14], p0[15])};
            pw[2] = (u32x4){cvtpk(p1[0], p1[1]), cvtpk(p1[2], p1[3]), cvtpk(p1[4], p1[5]), cvtpk(p1[6], p1[7])};
            pw[3] = (u32x4){cvtpk(p1[8], p1[9]), cvtpk(p1[10], p1[11]), cvtpk(p1[12], p1[13]), cvtpk(p1[14], p1[15])};
            if (!grpB) { __builtin_amdgcn_sched_barrier(0); ATT_PV(vfb + vsl * VSLOT); }
            else { pend = true; pvs = vsl; }
        }
        if (pre) { if (PROBE_PH == 22) { if (NVP == 2) asm volatile("s_waitcnt vmcnt(6) lgkmcnt(0)" ::: "memory"); else asm volatile("s_waitcnt vmcnt(4) lgkmcnt(0)" ::: "memory"); }
                   else if (NVP == 2) asm volatile("s_waitcnt vmcnt(3) lgkmcnt(0)" ::: "memory"); else asm volatile("s_waitcnt vmcnt(2) lgkmcnt(0)" ::: "memory"); }
        else asm volatile("s_waitcnt vmcnt(0) lgkmcnt(0)" ::: "memory");
        __builtin_amdgcn_s_barrier(); asm volatile("" ::: "memory");
        ksl2 = (ksl2 == 2) ? 0 : ksl2 + 1; ksl = (ksl == 2) ? 0 : ksl + 1; vsl2 = (vsl2 + 1) & 3; vsl = (vsl + 1) & 3;
    }
    if (grpB && pend) { ATT_PV(vfb + pvs * VSLOT); }
#undef ATT_PV
#undef ATT_VF
    { auto rr = __builtin_amdgcn_permlane32_swap(__float_as_uint(l), __float_as_uint(l), false, false); l = __uint_as_float(rr[0]) + __uint_as_float(rr[1]); }
    if (hi == 0) wsf[32 + r32] = l;
    { int hx = hi; asm volatile("" : "+v"(hx));
#pragma unroll
    for (int r = 0; r < 16; ++r) rli[r] = __builtin_amdgcn_rcpf(wsf[32 + crow(r, hx)]); }
#undef ATT_DMA
#undef ATT_WAITBAR
#undef ATT_CR
}

constexpr float OA8S = 8.f;
__device__ __forceinline__ u32x2 bf8_to_fp8(u32x4 w) {
    u32x2 r; int a = __builtin_amdgcn_cvt_pk_fp8_f32(__uint_as_float(w.x << 16) * OA8S, __uint_as_float(w.x & 0xffff0000u) * OA8S, 0, false);
    a = __builtin_amdgcn_cvt_pk_fp8_f32(__uint_as_float(w.y << 16) * OA8S, __uint_as_float(w.y & 0xffff0000u) * OA8S, a, true);
    int b = __builtin_amdgcn_cvt_pk_fp8_f32(__uint_as_float(w.z << 16) * OA8S, __uint_as_float(w.z & 0xffff0000u) * OA8S, 0, false);
    b = __builtin_amdgcn_cvt_pk_fp8_f32(__uint_as_float(w.w << 16) * OA8S, __uint_as_float(w.w & 0xffff0000u) * OA8S, b, true);
    r[0] = (unsigned)a; r[1] = (unsigned)b; return r; }
__device__ __forceinline__ void unit_a(LAS unsigned char* lds, const bf16_t* proj, float* oc, bf16_t* outab, const float* subw, float lam, gu32* acnt, LAS int* qbox, int b, int h, int cm, int qb, int tlo0, int tlo1, float kmax0, float kmax1) {
    const int tid = threadIdx.x, lane = tid & 63, r32 = lane & 31, hi = lane >> 5; const int wid = __builtin_amdgcn_readfirstlane(tid >> 6);
    const size_t rowb = (size_t)b * SEQ; const int q0 = qb * 256;
    const float slope2 = exp2f(-2.f * (float)(h + 1)) * LOG2E;
    const size_t grow0 = rowb + q0 + 32 * wid;
    const int c_begin = (cm == 2) ? 0 : cm, c_end = (cm == 2) ? 1 : cm;
#pragma unroll 1
    for (int c = c_begin; c <= c_end; ++c) {
        f32x16 o[4]; float rli[16];
        attn_pass<128, 0>(lds, proj, rowb, h * 128 + c * 64, 512 + h * 128 + c * 64, 1024 + h * 128, q0, c ? tlo1 : tlo0, 4 * qb + 3, slope2, nullptr, c ? kmax1 : kmax0, 0.f, o, rli);
#pragma unroll
        for (int r = 0; r < 16; ++r)
#pragma unroll
            for (int d = 0; d < 4; ++d) o[d][r] *= rli[r];
        int hx = hi; asm volatile("" : "+v"(hx));
        const unsigned ooff = (unsigned)((4 * hx) * 512 + (tid & 31)) * 4u;
        bool comb;
        if (cm == 2 && c == 1) comb = true;
        else if (cm == 2) {
            float* pv = oc + (size_t)blockIdx.x * (512 * 64) + (unsigned)tid * 4u;
#pragma unroll
            for (int r = 0; r < 16; ++r) GST(f32x4, pv + r * 2048) = (f32x4){o[0][r], o[1][r], o[2][r], o[3][r]};
            asm volatile("s_waitcnt vmcnt(0)" ::: "memory");
            comb = false;
        } else {
            char* ocb = (char*)(oc + (size_t)c * NTOK * 512 + grow0 * 512 + h * 128);
#pragma unroll
            for (int r = 0; r < 16; ++r) { float* op = (float*)(ocb + ooff + ((r & 3) + 8 * (r >> 2)) * 2048);
#pragma unroll
                for (int d = 0; d < 4; ++d) GST(float, op + d * 32) = o[d][r]; }
            asm volatile("s_waitcnt vmcnt(0)" ::: "memory");
            comb = false;
            if (cm != 2) {
                __syncthreads();
                if (tid == 0) { __builtin_amdgcn_fence(__ATOMIC_RELEASE, "agent"); asm volatile("s_waitcnt vmcnt(0)" ::: "memory");
                    const unsigned old = __hip_atomic_fetch_add(acnt + ((b * 4 + h) * 32 + qb), 1u, __ATOMIC_RELAXED, __HIP_MEMORY_SCOPE_AGENT);
                    if (old == 1u) { __builtin_amdgcn_fence(__ATOMIC_ACQUIRE, "agent"); asm volatile("s_waitcnt vmcnt(0)" ::: "memory"); }
                    qbox[4] = (int)old; }
                __syncthreads();
                comb = (__builtin_amdgcn_readfirstlane(qbox[4]) == 1);
            }
        }
        if (comb) {
            const char* ocb = (const char*)(oc + (size_t)(c ^ 1) * NTOK * 512 + grow0 * 512 + h * 128);
            float sw[4];
#pragma unroll
            for (int d = 0; d < 4; ++d) sw[d] = subw[d * 32 + r32];
            const float f0 = c ? -lam : 1.f, f1 = c ? 1.f : -lam;
            LAS bf16_t* st = (LAS bf16_t*)(lds + L_OST + wid * 8192) + (4 * hx) * 128 + r32;
            const float* pv = oc + (size_t)blockIdx.x * (512 * 64) + (unsigned)tid * 4u;
#pragma unroll
            for (int r = 0; r < 16; ++r) { const float* op = (const float*)(ocb + ooff + ((r & 3) + 8 * (r >> 2)) * 2048); float v[4]; float ss = 0.f;
                f32x4 s4;
                if (cm == 2) s4 = GLD(f32x4, pv + r * 2048); else { s4[0] = GLD(float, op); s4[1] = GLD(float, op + 32); s4[2] = GLD(float, op + 64); s4[3] = GLD(float, op + 96); }
#pragma unroll
                for (int d = 0; d < 4; ++d) { v[d] = f0 * o[d][r] + f1 * s4[d]; ss += v[d] * v[d]; }
                ss += __int_as_float(__builtin_amdgcn_update_dpp(0, __float_as_int(ss), 0xB1, 0xf, 0xf, true));
                ss += __int_as_float(__builtin_amdgcn_update_dpp(0, __float_as_int(ss), 0x4E, 0xf, 0xf, true));
                ss += __int_as_float(__builtin_amdgcn_update_dpp(0, __float_as_int(ss), 0x141, 0xf, 0xf, true));
                ss += __int_as_float(__builtin_amdgcn_update_dpp(0, __float_as_int(ss), 0x140, 0xf, 0xf, true));
                { const auto r_ = __builtin_amdgcn_permlane16_swap(__float_as_uint(ss), __float_as_uint(ss), false, false); ss = __uint_as_float(r_[0]) + __uint_as_float(r_[1]); }
                const float rinv = rsqrtf(ss * (1.f / 128.f) + LN_EPS) * (1.f - LAM_INIT);
#pragma unroll
                for (int d = 0; d < 4; ++d) st[((r & 3) + 8 * (r >> 2)) * 128 + d * 32] = (bf16_t)f2bf(v[d] * rinv * sw[d]);
                if ((r & 3) == 3) asm volatile("" ::: "memory"); }
            asm volatile("s_waitcnt lgkmcnt(0)" ::: "memory");
            int lx = lane; asm volatile("" : "+v"(lx));
            const LAS bf16_t* st2 = (const LAS bf16_t*)(lds + L_OST + wid * 8192) + (lx >> 4) * 128 + (lx & 15) * 8;
            char* oab = (char*)outab + (grow0 * D + h * 128) + (unsigned)((lx >> 4) * D + (lx & 15) * 8);
#pragma unroll
            for (int i = 0; i < 8; ++i) { const u32x4 w = *(const LAS u32x4*)(st2 + i * 4 * 128);
                GST(u32x2, oab + i * 4 * D) = bf8_to_fp8(w); }
            asm volatile("s_waitcnt vmcnt(0)" ::: "memory");
        }
    }
}
__device__ __forceinline__ void unit_b(LAS unsigned char* lds, const bf16_t* proj, bf16_t* outab, int b, int h, int qb, float kmax, float bmax) {
    const int tid = threadIdx.x, lane = tid & 63, r32 = lane & 31, hi = lane >> 5; const int wid = __builtin_amdgcn_readfirstlane(tid >> 6);
    const size_t rowb = (size_t)b * SEQ; const int q0 = qb * 256;
    f32x16 o[2]; float rli[16];
    const size_t grow0 = rowb + q0 + 32 * wid;
    const int tlo = 4 * qb - 8 < 0 ? 0 : 4 * qb - 8;
    attn_pass<64, 1>(lds, proj, rowb, 1536 + h * 64, 2048 + h * 64, 2560 + h * 64, q0, tlo, 4 * qb + 3, 0.f, (const LAS float*)(lds + L_TAB) + h * 257, kmax, bmax, o, rli);
    int hx = hi; asm volatile("" : "+v"(hx));
    LAS bf16_t* st = (LAS bf16_t*)(lds + L_OST + wid * 8192) + (4 * hx) * 64 + r32;
#pragma unroll
    for (int r = 0; r < 16; ++r)
#pragma unroll
        for (int d = 0; d < 2; ++d) st[((r & 3) + 8 * (r >> 2)) * 64 + d * 32] = (bf16_t)f2bf(o[d][r] * rli[r]);
    asm volatile("s_waitcnt lgkmcnt(0)" ::: "memory");
    int lx = lane; asm volatile("" : "+v"(lx));
    const LAS bf16_t* st2 = (const LAS bf16_t*)(lds + L_OST + wid * 8192) + (lx >> 3) * 64 + (lx & 7) * 8;
    char* oab = (char*)outab + (grow0 * D + 512 + h * 64) + (unsigned)((lx >> 3) * D + (lx & 7) * 8);
#pragma unroll
    for (int i = 0; i < 4; ++i) { const u32x4 w = *(const LAS u32x4*)(st2 + i * 8 * 64);
        GST(u32x2, oab + i * 8 * D) = bf8_to_fp8(w); }
    asm volatile("s_waitcnt vmcnt(0)" ::: "memory");
}
}

constexpr int RING_OFF = 0, RING_BYTES = 131072;
constexpr int MISC_OFF = 135168;
constexpr int TTAB_OFF = MISC_OFF + 256;
constexpr int TOKTAB_OFF = MISC_OFF + 8192;
constexpr int CONV_SCR6 = MISC_OFF + 256;
constexpr int LDS_BYTES = CONV_SCR6 + 16640;
constexpr int NWAVES = 8;
constexpr int CW_BAR = 4096;

#define XB_TMO      128
#define XB_XCNT(j)  (256  + 64 * (j))
#define XB_XSUB(j)  (1280 + 64 * (j))
#define XB_XGEN(j)  (2304 + 64 * (j))
#define XB_TOP      3328
#define XB_TOPGEN   3392
#define XCD_BAR_WORDS 3456
#define XB_SPIN_CAP (1u << 18)
__device__ __forceinline__ unsigned xb_ld(unsigned* p)              { return __hip_atomic_load(p, __ATOMIC_RELAXED, __HIP_MEMORY_SCOPE_AGENT); }
__device__ __forceinline__ unsigned xb_add(unsigned* p, unsigned v) { return __hip_atomic_fetch_add(p, v, __ATOMIC_RELAXED, __HIP_MEMORY_SCOPE_AGENT); }
__device__ __forceinline__ unsigned xb_xcc_id() { return (unsigned)__builtin_amdgcn_s_getreg((3 << 11) | 20) & 0xFu; }
#define XB_SPIN(cond, bar) do { unsigned _sp = 0; while (cond) { __builtin_amdgcn_s_sleep(1); \
    if ((++_sp & 255u) == 0u) { if (xb_ld(&(bar)[XB_TMO])) break; if (_sp > XB_SPIN_CAP) { atomicAdd(&(bar)[XB_TMO], 1u); break; } } } } while (0)
struct XcdBarrier { unsigned* bar; unsigned x; volatile LAS unsigned* st; };
__device__ __forceinline__ XcdBarrier xcd_barrier_post(unsigned* bar, volatile LAS unsigned* st) {
    XcdBarrier b; b.bar = bar; b.x = xb_xcc_id(); b.st = st;
    if (threadIdx.x == 0) (void)xb_add(&bar[XB_XCNT(b.x)], 1u);
    return b;
}
__device__ __forceinline__ void xcd_barrier_complete(unsigned* bar, unsigned x, unsigned& nloc, unsigned& nx) {
    const unsigned G = gridDim.x * gridDim.y * gridDim.z;
    unsigned sum, cnt, mine, sp = 0u;
    for (;;) {
        sum = 0u; cnt = 0u; mine = 0u;
#pragma unroll
        for (unsigned j = 0; j < 16; ++j) { const unsigned c = xb_ld(&bar[XB_XCNT(j)]); sum += c; cnt += (c > 0u) ? 1u : 0u; mine = (j == x) ? c : mine; }
        if (sum == G) break;
        __builtin_amdgcn_s_sleep(1);
        if ((++sp & 255u) == 0u) { if (xb_ld(&bar[XB_TMO])) break; if (sp > XB_SPIN_CAP) { atomicAdd(&bar[XB_TMO], 1u); break; } }
    }
    nloc = mine > 0u ? mine : 1u; nx = cnt > 0u ? cnt : 1u;
}
__device__ __forceinline__ void xcd_barrier(const XcdBarrier& b) {
    asm volatile("s_waitcnt vmcnt(0)" ::: "memory");
    __syncthreads();
    if (threadIdx.x == 0) {
        unsigned* bar = b.bar;
        __builtin_amdgcn_s_waitcnt(0);
        unsigned nloc = b.st[0], nx = b.st[1];
        if (nloc == 0u) { xcd_barrier_complete(bar, b.x, nloc, nx); b.st[0] = nloc; b.st[1] = nx; }
        const unsigned old = xb_add(&bar[XB_XSUB(b.x)], 1u);
        const unsigned gen = old / nloc;
        if (old + 1u == (gen + 1u) * nloc) {
            __builtin_amdgcn_fence(__ATOMIC_RELEASE, "agent");
            asm volatile("s_waitcnt vmcnt(0)" ::: "memory");
            const unsigned og = xb_add(&bar[XB_TOP], 1u);
            const unsigned tg = og / nx;
            if (og + 1u == (tg + 1u) * nx) xb_add(&bar[XB_TOPGEN], 1u);
            else XB_SPIN(xb_ld(&bar[XB_TOPGEN]) == tg, bar);
            __builtin_amdgcn_fence(__ATOMIC_ACQUIRE, "agent");
            xb_add(&bar[XB_XGEN(b.x)], 1u);
            asm volatile("s_waitcnt vmcnt(0)" ::: "memory");
        } else {
            XB_SPIN(xb_ld(&bar[XB_XGEN(b.x)]) == gen, bar);
            __builtin_amdgcn_fence(__ATOMIC_ACQUIRE, "agent");
            asm volatile("s_waitcnt vmcnt(0)" ::: "memory");
        }
    }
    __syncthreads();
}

struct Args {
    const float* in[24]; float* out; unsigned char* ws; int ph_lo, ph_hi, li, pad_;
};
static_assert(sizeof(Args) == 24 * 8 + 8 + 8 + 16, "Args has no padding");

__device__ __forceinline__ void p0_transpose_item(const float* W, int K, int N, bf16_t* WT, int k0, int n0, int rowbase, LAS float* scr, int lane) {
    const float* wp = W + (size_t)(k0 + (lane >> 4)) * N + n0 + (lane & 15) * 4;
    f32x4 v[16];
#pragma unroll
    for (int i = 0; i < 16; ++i) v[i] = *(const f32x4*)(wp + (size_t)(4 * i) * N);
#pragma unroll
    for (int i = 0; i < 16; ++i) { LAS float* d = scr + (4 * i + (lane >> 4)) * 65 + (lane & 15) * 4; d[0] = v[i][0]; d[1] = v[i][1]; d[2] = v[i][2]; d[3] = v[i][3]; }
    asm volatile("s_waitcnt lgkmcnt(0)" ::: "memory");
    const int c = lane & 7;
#pragma unroll
    for (int j = 0; j < 8; ++j) { const int n = (lane >> 3) + 8 * j; const LAS float* sp = scr + (8 * c) * 65 + n;
        u32x4 o; o.x = pg::cvt_pk_bf16(sp[0 * 65], sp[1 * 65]); o.y = pg::cvt_pk_bf16(sp[2 * 65], sp[3 * 65]); o.z = pg::cvt_pk_bf16(sp[4 * 65], sp[5 * 65]); o.w = pg::cvt_pk_bf16(sp[6 * 65], sp[7 * 65]);
        GST(u32x4, WT + (size_t)(rowbase + n) * K + k0 + 8 * c) = o; }
    asm volatile("s_waitcnt lgkmcnt(0)" ::: "memory");
}
constexpr float S8S = 64.f, S8SI = 1.f / 64.f;
constexpr float A8S = 4.f, A8SI = 0.25f;
constexpr float M8S = 16.f, M8SI = 1.f / 16.f;
constexpr float W8S = 64.f, W8SI = 1.f / 64.f;
__device__ __forceinline__ unsigned pack4_u8(float a, float b, float c, float d) {
    return (unsigned)(a + 0.5f) | ((unsigned)(b + 0.5f) << 8) | ((unsigned)(c + 0.5f) << 16) | ((unsigned)(d + 0.5f) << 24); }
__device__ __forceinline__ u32x4 widen16(u32x2 a, u32x2 b) {
    const auto r0 = __builtin_amdgcn_permlane16_swap(a[0], b[0], false, false); const auto r1 = __builtin_amdgcn_permlane16_swap(a[1], b[1], false, false);
    return (u32x4){r0[0], r1[0], r0[1], r1[1]}; }
__device__ __forceinline__ unsigned pack4_fp8(float a, float b, float c, float d) { int w = __builtin_amdgcn_cvt_pk_fp8_f32(a, b, 0, false); w = __builtin_amdgcn_cvt_pk_fp8_f32(c, d, w, true); return (unsigned)w; }
__device__ __forceinline__ void p0_transpose_item_f8(const float* W, int K, int N, unsigned char* WT, int k0, int n0, int rowbase, LAS float* scr, int lane) {
    const float* wp = W + (size_t)(k0 + (lane >> 4)) * N + n0 + (lane & 15) * 4;
    f32x4 v[16];
#pragma unroll
    for (int i = 0; i < 16; ++i) v[i] = *(const f32x4*)(wp + (size_t)(4 * i) * N);
#pragma unroll
    for (int i = 0; i < 16; ++i) { LAS float* d = scr + (4 * i + (lane >> 4)) * 65 + (lane & 15) * 4; d[0] = v[i][0]; d[1] = v[i][1]; d[2] = v[i][2]; d[3] = v[i][3]; }
    asm volatile("s_waitcnt lgkmcnt(0)" ::: "memory");
    const int c = lane & 3;
#pragma unroll
    for (int j = 0; j < 4; ++j) { const int n = (lane >> 2) + 16 * j; const LAS float* sp = scr + (16 * c) * 65 + n;
        u32x4 o;
        o.x = pack4_fp8(sp[0 * 65] * W8S, sp[1 * 65] * W8S, sp[2 * 65] * W8S, sp[3 * 65] * W8S); o.y = pack4_fp8(sp[4 * 65] * W8S, sp[5 * 65] * W8S, sp[6 * 65] * W8S, sp[7 * 65] * W8S);
        o.z = pack4_fp8(sp[8 * 65] * W8S, sp[9 * 65] * W8S, sp[10 * 65] * W8S, sp[11 * 65] * W8S); o.w = pack4_fp8(sp[12 * 65] * W8S, sp[13 * 65] * W8S, sp[14 * 65] * W8S, sp[15 * 65] * W8S);
        GST(u32x4, WT + (size_t)(rowbase + n) * K + k0 + 16 * c) = o; }
    asm volatile("s_waitcnt lgkmcnt(0)" ::: "memory");
}
struct P0Item { const float* W; unsigned char* WT; int N, K, k0, n0, rowbase, f8; };
__device__ __forceinline__ void p0_load(const P0Item& I, f32x4 (&v)[16], int lane) {
    const float* wp = I.W + (size_t)(I.k0 + (lane >> 4)) * I.N + I.n0 + (lane & 15) * 4;
#pragma unroll
    for (int i = 0; i < 16; ++i) v[i] = *(const f32x4*)(wp + (size_t)(4 * i) * I.N);
}
__device__ __forceinline__ void p0_proc(const P0Item& I, const f32x4 (&v)[16], LAS float* scr, int lane) {
#pragma unroll
    for (int i = 0; i < 16; ++i) { LAS float* d = scr + (4 * i + (lane >> 4)) * 65 + (lane & 15) * 4; d[0] = v[i][0]; d[1] = v[i][1]; d[2] = v[i][2]; d[3] = v[i][3]; }
    asm volatile("s_waitcnt lgkmcnt(0)" ::: "memory");
    if (I.f8) { const int c = lane & 3;
#pragma unroll
        for (int j = 0; j < 4; ++j) { const int n = (lane >> 2) + 16 * j; const LAS float* sp = scr + (16 * c) * 65 + n;
            u32x4 o;
            o.x = pack4_fp8(sp[0 * 65] * W8S, sp[1 * 65] * W8S, sp[2 * 65] * W8S, sp[3 * 65] * W8S); o.y = pack4_fp8(sp[4 * 65] * W8S, sp[5 * 65] * W8S, sp[6 * 65] * W8S, sp[7 * 65] * W8S);
            o.z = pack4_fp8(sp[8 * 65] * W8S, sp[9 * 65] * W8S, sp[10 * 65] * W8S, sp[11 * 65] * W8S); o.w = pack4_fp8(sp[12 * 65] * W8S, sp[13 * 65] * W8S, sp[14 * 65] * W8S, sp[15 * 65] * W8S);
            GST(u32x4, I.WT + (size_t)(I.rowbase + n) * I.K + I.k0 + 16 * c) = o; }
    } else { const int c = lane & 7;
#pragma unroll
        for (int j = 0; j < 8; ++j) { const int n = (lane >> 3) + 8 * j; const LAS float* sp = scr + (8 * c) * 65 + n;
            u32x4 o; o.x = pg::cvt_pk_bf16(sp[0 * 65], sp[1 * 65]); o.y = pg::cvt_pk_bf16(sp[2 * 65], sp[3 * 65]); o.z = pg::cvt_pk_bf16(sp[4 * 65], sp[5 * 65]); o.w = pg::cvt_pk_bf16(sp[6 * 65], sp[7 * 65]);
            GST(u32x4, I.WT + ((size_t)(I.rowbase + n) * I.K + I.k0 + 8 * c) * 2) = o; }
    }
    asm volatile("s_waitcnt lgkmcnt(0)" ::: "memory");
}
template <int R>
__device__ __forceinline__ void ln_rows_in(const float* x, const float* g, const float* b, bf16_t* xn, unsigned char* xn8, int row0, int rstride, int lane) {
    float4 v[R][4];
#pragma unroll
    for (int q = 0; q < R; ++q) { const float4* xr = (const float4*)(x + (size_t)(row0 + q * rstride) * D) + lane;
#pragma unroll
        for (int j = 0; j < 4; ++j) v[q][j] = xr[64 * j]; }
#pragma unroll
    for (int q = 0; q < R; ++q) { const int row = row0 + q * rstride; float s = 0.f;
#pragma unroll
        for (int j = 0; j < 4; ++j) s += (v[q][j].x + v[q][j].y) + (v[q][j].z + v[q][j].w);
        const float mean = wave_sum(s) * (1.f / D); float s2 = 0.f;
#pragma unroll
        for (int j = 0; j < 4; ++j) { v[q][j].x -= mean; v[q][j].y -= mean; v[q][j].z -= mean; v[q][j].w -= mean; s2 += (v[q][j].x * v[q][j].x + v[q][j].y * v[q][j].y) + (v[q][j].z * v[q][j].z + v[q][j].w * v[q][j].w); }
        const float rstd = rsqrtf(wave_sum(s2) * (1.f / D) + LN_EPS);
#pragma unroll
        for (int j = 0; j < 4; ++j) {
            const int c = (lane + 64 * j) * 4; const float4 gg = *(const float4*)(g + c), bb = *(const float4*)(b + c);
            const float h0 = v[q][j].x * rstd * gg.x + bb.x, h1 = v[q][j].y * rstd * gg.y + bb.y, h2 = v[q][j].z * rstd * gg.z + bb.z, h3 = v[q][j].w * rstd * gg.w + bb.w;
            uint2 o; o.x = f2bf(h0) | (f2bf(h1) << 16); o.y = f2bf(h2) | (f2bf(h3) << 16);
            GST(u32x2, xn + (size_t)row * D + c) = (u32x2){o.x, o.y};
            { const unsigned w0 = pack4_fp8(h0, h1, h2, h3); const unsigned w1 = __shfl_down(w0, 1), w2 = __shfl_down(w0, 2), w3 = __shfl_down(w0, 3);
              if ((lane & 3) == 0) GST(u32x4, xn8 + (size_t)row * D + c) = (u32x4){w0, w1, w2, w3}; }
        } }
}

struct EpiProj {
    static constexpr bool BIASLDS = false; static constexpr bool ROWINFO = false; static constexpr bool PERM = true;
    bf16_t* O; int* nrmsq;
    __device__ __forceinline__ bool operator()(f32x4 (&acc)[2][2][4][2], const pg::Unit& u, int wr, int wc, int fr, int fq) const {
        const int row0 = u.pm * 256 + wr * 64 + fr, col0 = u.pn * 256 + wc * 32 + 8 * fq;
        const int kind = (u.pn < 2 || (u.pn >= 6 && u.pn < 8)) ? 1 : 0;
        if (u.pn < 4 || u.pn == 8 || u.pn == 9) {
            const int nk = u.pn < 2 ? 1 : (u.pn < 4 ? 0 : 2); const float sc = u.pn < 2 ? C2 : 1.f; const int bb_ = u.pm >> 5;
#pragma unroll
            for (int ai = 0; ai < 2; ++ai)
#pragma unroll
                for (int bj = 0; bj < 2; ++bj) { float mx = 0.f;
#pragma unroll
                    for (int m = 0; m < 4; ++m) { const f32x4 a0 = acc[ai][bj][m][0] * sc, a1 = acc[ai][bj][m][1] * sc;
                        float ss = (a0[0] * a0[0] + a0[1] * a0[1]) + (a0[2] * a0[2] + a0[3] * a0[3]) + (a1[0] * a1[0] + a1[1] * a1[1]) + (a1[2] * a1[2] + a1[3] * a1[3]);
                        ss += __shfl_xor(ss, 16); ss += __shfl_xor(ss, 32); mx = fmaxf(mx, ss); }
                    mx = fmaxf(mx, __shfl_xor(mx, 1)); mx = fmaxf(mx, __shfl_xor(mx, 2)); mx = fmaxf(mx, __shfl_xor(mx, 4)); mx = fmaxf(mx, __shfl_xor(mx, 8));
                    const int head = nk == 2 ? (bb_ * 8 + 4 * (u.pn - 8) + 2 * bj + (wc >> 1)) : ((bb_ * 4 + 2 * (u.pn & 1) + bj) * 2 + (wc >> 1));
                    const int tl = 4 * (u.pm & 31) + 2 * ai + wr;
                    if (fr == 0 && fq == 0) __hip_atomic_fetch_max(nrmsq + (nk * 32 + head) * 128 + tl, (int)__float_as_uint(mx), __ATOMIC_RELAXED, __HIP_MEMORY_SCOPE_AGENT); }
        }
#pragma unroll
        for (int ai = 0; ai < 2; ++ai)
#pragma unroll
            for (int m = 0; m < 4; ++m) { bf16_t* rowp = O + (size_t)(row0 + ai * 128 + m * 16) * INC + col0;
#pragma unroll
                for (int bj = 0; bj < 2; ++bj) { f32x4 v0 = acc[ai][bj][m][0], v1 = acc[ai][bj][m][1];
                    if (kind == 1) { v0 = v0 * C2; v1 = v1 * C2; }
                    u32x4 w; w.x = pg::cvt_pk_bf16(v0[0], v0[1]); w.y = pg::cvt_pk_bf16(v0[2], v0[3]); w.z = pg::cvt_pk_bf16(v1[0], v1[1]); w.w = pg::cvt_pk_bf16(v1[2], v1[3]);
                    GST(u32x4, rowp + bj * 128) = w; } }
        return false;
    }
};
struct EpiGates {
    static constexpr bool BIASLDS = true; static constexpr bool ROWINFO = false; static constexpr bool PERM = true; static constexpr int NST = 8;
    unsigned char* G; const float* bgate; float gscale;
    __device__ __forceinline__ const float* bias_src(const pg::Unit& u, int lane) const { return bgate + (u.pn - 12) * 256 + lane * 4; }
    __device__ __forceinline__ bool operator()(f32x4 (&acc)[2][2][4][2], const pg::Unit& u, int wr, int wc, int fr, int fq, const LAS float* bl) const {
        const int col0 = wc * 32 + 8 * fq;
        const unsigned tid_ = (unsigned)((wr * 4 + wc) * 64 + fq * 16 + fr);
        unsigned char* gb = G + ((size_t)(u.pm * 8 + (u.pn - 12)) * 8) * 8192 + tid_ * 16u;
        f32x2 bv[2][4];
#pragma unroll
        for (int bj = 0; bj < 2; ++bj)
#pragma unroll
            for (int h = 0; h < 4; ++h) bv[bj][h] = *(const LAS f32x2*)(bl + col0 + bj * 128 + 2 * h) * (-LOG2E);
        const f32x2 kn = {-LOG2E * gscale, -LOG2E * gscale}, one = {1.f, 1.f}, k255 = {255.f, 255.f}, magic = {8388608.f, 8388608.f};
#pragma unroll
        for (int ai = 0; ai < 2; ++ai)
#pragma unroll
            for (int m = 0; m < 4; ++m) { u32x2 gwv[2];
#pragma unroll
                for (int bj = 0; bj < 2; ++bj) { unsigned zb[8];
#pragma unroll
                    for (int h = 0; h < 4; ++h) { const f32x4 av = acc[ai][bj][m][h >> 1];
                        f32x2 e = (f32x2){av[2 * (h & 1)], av[2 * (h & 1) + 1]} * kn + bv[bj][h];
                        e[0] = __builtin_amdgcn_exp2f(e[0]); e[1] = __builtin_amdgcn_exp2f(e[1]); e = e + one;
                        e[0] = __builtin_amdgcn_rcpf(e[0]); e[1] = __builtin_amdgcn_rcpf(e[1]); e = e * k255 + magic;
                        zb[2 * h] = __float_as_uint(e[0]); zb[2 * h + 1] = __float_as_uint(e[1]); }
                    gwv[bj].x = __builtin_amdgcn_perm(zb[1], zb[0], 0x0c0c0400u) | (__builtin_amdgcn_perm(zb[3], zb[2], 0x0c0c0400u) << 16);
                    gwv[bj].y = __builtin_amdgcn_perm(zb[5], zb[4], 0x0c0c0400u) | (__builtin_amdgcn_perm(zb[7], zb[6], 0x0c0c0400u) << 16); }
                GST(u32x4, gb + (ai * 4 + m) * 8192) = (u32x4){gwv[0].x, gwv[0].y, gwv[1].x, gwv[1].y}; }
        return false;
    }
};
struct SchedDense {
    pg::GridOrder go; const char* A; const char* B; size_t tstepA, tstepB; int pn_off;
    __device__ __forceinline__ bool next(int i, pg::Unit& u) const { int pm, pn; if (!go.tile(i, pm, pn)) return false; u.pm = pm; u.pn = pn + pn_off; u.x0 = 0; u.x1 = 0; u.x2 = 0; u.x3 = 0; u.A = A + (size_t)pm * tstepA; u.B = B + (size_t)pn * tstepB; return true; }
};

__device__ __forceinline__ float bflo(unsigned w) { return __uint_as_float(w << 16); }
__device__ __forceinline__ float bfhi(unsigned w) { return __uint_as_float(w & 0xffff0000u); }
struct EpiMerged {
    static constexpr bool BIASLDS = false; static constexpr bool ROWINFO = false; static constexpr bool PERM = true; static constexpr int NST = 0;
    const unsigned char* G; bf16_t* merged;
    __device__ __forceinline__ bool operator()(f32x4 (&acc)[2][2][4][2], const pg::Unit& u, int wr, int wc, int fr, int fq) const {
        const int row0 = u.pm * 256 + wr * 64 + fr, col0 = u.pn * 256 + wc * 32 + 8 * fq; const bool first = (u.x0 == 0);
        const unsigned tid_ = (unsigned)((wr * 4 + wc) * 64 + fq * 16 + fr);
        const unsigned char* g0b = G + ((size_t)(u.pm * 8 + u.pn) * 8) * 8192 + tid_ * 16u; const unsigned char* g1b = g0b + (size_t)4 * 8 * 8192;
#pragma unroll
        for (int ai = 0; ai < 2; ++ai)
#pragma unroll
            for (int m = 0; m < 4; ++m) { const size_t row = (size_t)(row0 + ai * 128 + m * 16);
                const u32x4 g1q = GLD(u32x4, g1b + (ai * 4 + m) * 8192); u32x4 g0q = {0u, 0u, 0u, 0u}; if (first) g0q = GLD(u32x4, g0b + (ai * 4 + m) * 8192);
#pragma unroll
                for (int bj = 0; bj < 2; ++bj) {
                    const unsigned g1x = bj ? g1q.z : g1q.x, g1y = bj ? g1q.w : g1q.y;
                    float g1[8];
#pragma unroll
                    for (int q = 0; q < 4; ++q) { g1[q] = fmaxf((float)((g1x >> (8 * q)) & 255u), 1e-30f); g1[4 + q] = fmaxf((float)((g1y >> (8 * q)) & 255u), 1e-30f); }
                    if (first) {
                        const unsigned g0x = bj ? g0q.z : g0q.x, g0y = bj ? g0q.w : g0q.y;
#pragma unroll
                        for (int q = 0; q < 4; ++q) { acc[ai][bj][m][0][q] *= (float)((g0x >> (8 * q)) & 255u) * __builtin_amdgcn_rcpf(g1[q]); acc[ai][bj][m][1][q] *= (float)((g0y >> (8 * q)) & 255u) * __builtin_amdgcn_rcpf(g1[4 + q]); }
                    } else {
                        f32x4 v0 = acc[ai][bj][m][0], v1 = acc[ai][bj][m][1];
#pragma unroll
                        for (int q = 0; q < 4; ++q) { v0[q] *= g1[q] * (M8S / 255.f * W8SI / att::OA8S); v1[q] *= g1[4 + q] * (M8S / 255.f * W8SI / att::OA8S); }
                        u32x2 w; w.x = pack4_fp8(v0[0], v0[1], v0[2], v0[3]); w.y = pack4_fp8(v1[0], v1[1], v1[2], v1[3]);
                        GST(u32x2, (unsigned char*)merged + row * D + col0 + bj * 128) = w;
                    } } }
        return first;
    }
};
struct SchedMerged {
    pg::GridOrder go; const char* outab; const char* wa; const char* wb;
    __device__ __forceinline__ bool next(int i, pg::Unit& u) const { int pm, pn; if (!go.tile(i >> 1, pm, pn)) return false; const int br = i & 1; u.pm = pm; u.pn = pn; u.x0 = br; u.x1 = 0; u.x2 = 0; u.x3 = 0;
        u.A = outab + (size_t)pm * 256 * 1024 + br * 512; u.B = (br ? wb : wa) + (size_t)pn * 256 * 512; return true; }
};
struct EpiY {
    static constexpr bool BIASLDS = false; static constexpr bool ROWINFO = false; static constexpr bool PERM = true;
    bf16_t* o;
    __device__ __forceinline__ bool operator()(f32x4 (&acc)[2][2][4][2], const pg::Unit& u, int wr, int wc, int fr, int fq) const {
        const int row0 = u.pm * 256 + wr * 64 + fr, col0 = u.pn * 256 + wc * 32 + 8 * fq;
#pragma unroll
        for (int ai = 0; ai < 2; ++ai)
#pragma unroll
            for (int m = 0; m < 4; ++m) { bf16_t* rowp = o + (size_t)(row0 + ai * 128 + m * 16) * D + col0;
#pragma unroll
                for (int bj = 0; bj < 2; ++bj) { const f32x4 v0 = acc[ai][bj][m][0] * (W8SI * M8SI), v1 = acc[ai][bj][m][1] * (W8SI * M8SI);
                    u32x4 w; w.x = pg::cvt_pk_bf16(v0[0], v0[1]); w.y = pg::cvt_pk_bf16(v0[2], v0[3]); w.z = pg::cvt_pk_bf16(v1[0], v1[1]); w.w = pg::cvt_pk_bf16(v1[2], v1[3]);
                    GST(u32x4, rowp + bj * 128) = w; } }
        return false;
    }
};
__device__ __forceinline__ void build_tile_table(LAS int* tt, const gu32* cnt, int tid) {
    LAS int* texp = tt; LAS int* tpos = tt + MAXT; LAS int* lcnt = tt + 2 * MAXT; LAS int* ntl = tt + 2 * MAXT + 32;
    if (tid < 32) lcnt[tid] = (int)__hip_atomic_load(cnt + tid, __ATOMIC_RELAXED, __HIP_MEMORY_SCOPE_AGENT);
    __syncthreads();
    if (tid < 32) { int base = 0; for (int e = 0; e < tid; ++e) base += (lcnt[e] + 255) >> 8; const int n = (lcnt[tid] + 255) >> 8;
        for (int j = 0; j < n; ++j) { texp[base + j] = tid; tpos[base + j] = j * 256; } if (tid == 31) ntl[0] = base + n; }
    __syncthreads();
}
struct SchedExpert {
    pg::GridOrder go; LAS int* tt; const char* A; const char* B; size_t bstride_e, bstride_n, astride_t; bool gatherA;
    __device__ __forceinline__ bool next(int i, pg::Unit& u) const { int t, pn; if (!go.tile(i, t, pn)) return false;
        const int e = __builtin_amdgcn_readfirstlane(tt[t]), tp = __builtin_amdgcn_readfirstlane(tt[MAXT + t]), n = __builtin_amdgcn_readfirstlane(tt[2 * MAXT + e]);
        u.pm = t; u.pn = pn; u.x0 = e; u.x1 = tp; u.x2 = n; u.x3 = e * LCAP + tp;
        u.A = gatherA ? A : A + (size_t)t * astride_t; u.B = B + (size_t)e * bstride_e + (size_t)pn * bstride_n; return true; }
};
struct EpiSwiglu {
    static constexpr bool BIASLDS = true; static constexpr bool ROWINFO = false; static constexpr bool PERM = true;
    const float* bias; bf16_t* abuf;
    __device__ __forceinline__ const float* bias_src(const pg::Unit& u, int lane) const { return bias + (size_t)u.x0 * 2 * DFF + (lane >= 32 ? DFF : 0) + u.pn * 128 + (lane & 31) * 4; }
    __device__ __forceinline__ bool operator()(f32x4 (&acc)[2][2][4][2], const pg::Unit& u, int wr, int wc, int fr, int fq, const LAS float* bl) const {
        const int row0 = u.pm * 256 + wr * 64 + fr, j0 = u.pn * 128 + wc * 32 + 8 * fq; const LAS float* bp = bl + wc * 32 + 8 * fq;
        f32x2 bg[4], bu[4];
#pragma unroll
        for (int h = 0; h < 4; ++h) { bg[h] = *(const LAS f32x2*)(bp + 2 * h); const f32x2 t = *(const LAS f32x2*)(bp + 128 + 2 * h); bu[h] = (t + 1.f) * A8S; }
        const f32x2 kg = {W8SI, W8SI}, ku = {W8SI * A8S, W8SI * A8S}, ke = {-SWA * LOG2E, -SWA * LOG2E}, one = {1.f, 1.f};
        u32x2 wm[2];
#pragma unroll
        for (int ai = 0; ai < 2; ++ai)
#pragma unroll
            for (int m = 0; m < 4; ++m) {
                f32x2 a[4];
#pragma unroll
                for (int h = 0; h < 4; ++h) { const f32x4 ag = acc[ai][0][m][h >> 1], au = acc[ai][1][m][h >> 1];
                    f32x2 g = (f32x2){ag[2 * (h & 1)], ag[2 * (h & 1) + 1]} * kg + bg[h], uu = (f32x2){au[2 * (h & 1)], au[2 * (h & 1) + 1]} * ku + bu[h];
                    g[0] = fminf(g[0], SWL); g[1] = fminf(g[1], SWL);
                    uu[0] = __builtin_amdgcn_fmed3f(uu[0], (1.f - SWL) * A8S, (1.f + SWL) * A8S); uu[1] = __builtin_amdgcn_fmed3f(uu[1], (1.f - SWL) * A8S, (1.f + SWL) * A8S);
                    f32x2 e = g * ke; e[0] = __builtin_amdgcn_exp2f(e[0]); e[1] = __builtin_amdgcn_exp2f(e[1]);
                    e = e + one; e[0] = __builtin_amdgcn_rcpf(e[0]); e[1] = __builtin_amdgcn_rcpf(e[1]);
                    a[h] = (g * e) * uu; }
                wm[m & 1].x = pack4_fp8(a[0][0], a[0][1], a[1][0], a[1][1]); wm[m & 1].y = pack4_fp8(a[2][0], a[2][1], a[3][0], a[3][1]);
                if (m & 1) { const size_t row = (size_t)(row0 + ai * 128 + (m - 1 + (fq & 1)) * 16);
                    GST(u32x4, (unsigned char*)abuf + row * DFF + j0 - 8 * (fq & 1)) = widen16(wm[0], wm[1]); } }
        return false;
    }
};
struct EpiScatter {
    static constexpr bool BIASLDS = true; static constexpr bool ROWINFO = true; static constexpr bool PERM = true;
    const float* bias; const float* listw; bf16_t* slot;
    __device__ __forceinline__ const float* bias_src(const pg::Unit& u, int lane) const { return bias + (size_t)u.x0 * D + u.pn * 256 + lane * 4; }
    __device__ __forceinline__ bool operator()(f32x4 (&acc)[2][2][4][2], const pg::Unit& u, int wr, int wc, int fr, int fq, const LAS unsigned* tab, const LAS float* bl) const {
        const int r0 = wr * 64 + fr, col0 = u.pn * 256 + wc * 32 + 8 * fq; const LAS float* bp = bl + wc * 32 + 8 * fq;
        const int colw = (fq & 1) ? col0 - 8 + 128 : col0;
        f32x4 bv[2][2];
#pragma unroll
        for (int bj = 0; bj < 2; ++bj)
#pragma unroll
            for (int n = 0; n < 2; ++n) bv[bj][n] = *(const LAS f32x4*)(bp + bj * 128 + 4 * n);
#pragma unroll
        for (int ai = 0; ai < 2; ++ai)
#pragma unroll
            for (int m = 0; m < 4; ++m) { const int r = r0 + ai * 128 + m * 16; const bool valid = (u.x1 + r) < u.x2;
                const int sl = valid ? (int)tab[r] : NTOK * 4; const float wg2 = __uint_as_float(tab[512 + r]) * S8S;
                u32x2 w[2];
#pragma unroll
                for (int bj = 0; bj < 2; ++bj) { const f32x4 v0 = (acc[ai][bj][m][0] * (W8SI * A8SI) + bv[bj][0]) * wg2, v1 = (acc[ai][bj][m][1] * (W8SI * A8SI) + bv[bj][1]) * wg2;
                    w[bj].x = pack4_fp8(v0[0], v0[1], v0[2], v0[3]); w[bj].y = pack4_fp8(v1[0], v1[1], v1[2], v1[3]); }
                GST(u32x4, (unsigned char*)slot + (size_t)sl * D + colw) = widen16(w[0], w[1]); }
        return false;
    }
};
__device__ __forceinline__ void split8(const f32x4 x0, const f32x4 x1, bf16x8& hi, bf16x8& lo) {
    u32x4 h; h.x = pg::cvt_pk_bf16(x0[0], x0[1]); h.y = pg::cvt_pk_bf16(x0[2], x0[3]); h.z = pg::cvt_pk_bf16(x1[0], x1[1]); h.w = pg::cvt_pk_bf16(x1[2], x1[3]);
    u32x4 l; l.x = pg::cvt_pk_bf16(x0[0] - bflo(h.x), x0[1] - bfhi(h.x)); l.y = pg::cvt_pk_bf16(x0[2] - bflo(h.y), x0[3] - bfhi(h.y));
    l.z = pg::cvt_pk_bf16(x1[0] - bflo(h.z), x1[1] - bfhi(h.z)); l.w = pg::cvt_pk_bf16(x1[2] - bflo(h.w), x1[3] - bfhi(h.w));
    hi = __builtin_bit_cast(bf16x8, h); lo = __builtin_bit_cast(bf16x8, l); }
__device__ __forceinline__ void p5_router(LAS unsigned char* lds, const bf16_t* xnb, const float* g0, const float* b0, const bf16_t* att, float2* st1, const float* g, const float* b, const float* wr, const float* br, bf16_t* h1b, unsigned char* h1f8, int* topi, float* topw, gu32* cnt, int* list, float* listw, int rowbase, int tid, int lane, int wave) {
    LAS float* hs = (LAS float*)lds;
    LAS float* part = (LAS float*)(lds + 65536);
    LAS unsigned* hist = (LAS unsigned*)(lds + 65536 + 16384);
    LAS unsigned* basep = hist + 32;
    LAS unsigned short* sle = (LAS unsigned short*)(lds + 65536 + 16384 + 256);
    LAS unsigned short* slp = sle + 512;
    LAS float* slw = (LAS float*)(slp + 512);
    const int e = lane & 31, half = lane >> 5, d0 = wave * 128 + half * 64;
    if (tid < 32) hist[tid] = 0u;
    LAS float* lnp = (LAS float*)(lds + CONV_SCR6);
    { const float* src = tid < 256 ? g0 : b0; const float* src1 = tid < 256 ? g : b; const int c4 = (tid & 255) * 4;
      *(LAS f32x4*)(lnp + (tid >> 8) * 1024 + c4) = *(const f32x4*)(src + c4); *(LAS f32x4*)(lnp + 2048 + (tid >> 8) * 1024 + c4) = *(const f32x4*)(src1 + c4); }
    const int fr = lane & 15, fq = lane >> 4; (void)half; (void)d0;
    bf16x8 bh[4][2], bl[4][2];
#pragma unroll
    for (int sx = 0; sx < 4; ++sx)
#pragma unroll
        for (int nt = 0; nt < 2; ++nt) { const float* wp = wr + (size_t)(wave * 128 + 32 * sx + 8 * fq) * NE + nt * 16 + fr;
            const f32x4 w0 = {wp[0], wp[NE], wp[2 * NE], wp[3 * NE]}, w1 = {wp[4 * NE], wp[5 * NE], wp[6 * NE], wp[7 * NE]};
            split8(w0, w1, bh[sx][nt], bl[sx][nt]); }
    __syncthreads();
    uint2 vy[2][4];
    LAS unsigned char* astg = lds + 98304 + wave * 4096;
#define P5_ATT_DMA(row_) do { _Pragma("unroll") for (int rr_ = 0; rr_ < 2; ++rr_) _Pragma("unroll") for (int q_ = 0; q_ < 2; ++q_) \
        __builtin_amdgcn_global_load_lds((const unsigned*)((const char*)(att + (size_t)((row_) + rr_) * D) + q_ * 1024 + lane * 16), (LAS unsigned*)(astg + rr_ * 2048 + q_ * 1024), 16, 0, 0); } while (0)
#pragma unroll
    for (int rr = 0; rr < 2; ++rr) { const size_t ro = (size_t)(rowbase + 2 * wave + rr) * D; const uint2* yr = (const uint2*)(xnb + ro) + lane;
#pragma unroll
        for (int j = 0; j < 4; ++j) vy[rr][j] = yr[64 * j]; }
    P5_ATT_DMA(rowbase + 2 * wave);
#pragma unroll 1
    for (int pass = 0; pass < 8; ++pass) {
        asm volatile("s_waitcnt vmcnt(0)" ::: "memory");
#pragma unroll
        for (int rr = 0; rr < 2; ++rr) {
            const int r = 2 * wave + rr, row = rowbase + pass * 16 + r;
            float4 v[4]; float s = 0.f;
            int lx = lane; asm volatile("" : "+v"(lx));
#pragma unroll
            for (int j = 0; j < 4; ++j) { const uint2 xw = vy[rr][j]; const u32x2 aw_ = *(const LAS u32x2*)(astg + rr * 2048 + (lx + 64 * j) * 8); uint2 aw; aw.x = aw_[0]; aw.y = aw_[1];
                v[j].x = fmaf(bflo(xw.x), ALPHA, bflo(aw.x)); v[j].y = fmaf(bfhi(xw.x), ALPHA, bfhi(aw.x)); v[j].z = fmaf(bflo(xw.y), ALPHA, bflo(aw.y)); v[j].w = fmaf(bfhi(xw.y), ALPHA, bfhi(aw.y));
                s += (v[j].x + v[j].y) + (v[j].z + v[j].w); }
            const float mean = wave_sum(s) * (1.f / D); float s2 = 0.f;
#pragma unroll
            for (int j = 0; j < 4; ++j) { v[j].x -= mean; v[j].y -= mean; v[j].z -= mean; v[j].w -= mean; s2 += (v[j].x * v[j].x + v[j].y * v[j].y) + (v[j].z * v[j].z + v[j].w * v[j].w); }
            const float rstd = rsqrtf(wave_sum(s2) * (1.f / D) + LN_EPS);
            if (lane == 0) GST(f32x2, st1 + row) = (f32x2){mean, rstd};
#pragma unroll
            for (int j = 0; j < 4; ++j) {
                const int c = (lx + 64 * j) * 4; const f32x4 gg = *(const LAS f32x4*)(lnp + 2048 + c), bb = *(const LAS f32x4*)(lnp + 3072 + c);
                float4 h; h.x = v[j].x * rstd * gg.x + bb.x; h.y = v[j].y * rstd * gg.y + bb.y; h.z = v[j].z * rstd * gg.z + bb.z; h.w = v[j].w * rstd * gg.w + bb.w;
                *(LAS f32x4*)(hs + r * D + c) = (f32x4){h.x, h.y, h.z, h.w};
                { const unsigned w0 = pack4_fp8(h.x, h.y, h.z, h.w); const unsigned w1 = __shfl_down(w0, 1), w2 = __shfl_down(w0, 2), w3 = __shfl_down(w0, 3);
                  if ((lane & 3) == 0) GST(u32x4, h1f8 + (size_t)row * D + c) = (u32x4){w0, w1, w2, w3}; }
            }
        }
        if (pass < 7) {
#pragma unroll
            for (int rr = 0; rr < 2; ++rr) { const size_t ro = (size_t)(rowbase + (pass + 1) * 16 + 2 * wave + rr) * D; const uint2* yn = (const uint2*)(xnb + ro) + lane;
#pragma unroll
                for (int j = 0; j < 4; ++j) vy[rr][j] = yn[64 * j]; }
            asm volatile("s_waitcnt lgkmcnt(0)" ::: "memory");
            P5_ATT_DMA(rowbase + (pass + 1) * 16 + 2 * wave); }
        __syncthreads();
        {
            f32x4 ac0 = {0.f, 0.f, 0.f, 0.f}, ac1 = {0.f, 0.f, 0.f, 0.f};
#pragma unroll
            for (int sx = 0; sx < 4; ++sx) { const LAS float* hp = hs + fr * D + wave * 128 + 32 * sx + 8 * fq;
                bf16x8 ah, al; split8(*(const LAS f32x4*)hp, *(const LAS f32x4*)(hp + 4), ah, al);
                ac0 = __builtin_amdgcn_mfma_f32_16x16x32_bf16(ah, bh[sx][0], ac0, 0, 0, 0); ac1 = __builtin_amdgcn_mfma_f32_16x16x32_bf16(ah, bh[sx][1], ac1, 0, 0, 0);
                ac0 = __builtin_amdgcn_mfma_f32_16x16x32_bf16(ah, bl[sx][0], ac0, 0, 0, 0); ac1 = __builtin_amdgcn_mfma_f32_16x16x32_bf16(ah, bl[sx][1], ac1, 0, 0, 0);
                ac0 = __builtin_amdgcn_mfma_f32_16x16x32_bf16(al, bh[sx][0], ac0, 0, 0, 0); ac1 = __builtin_amdgcn_mfma_f32_16x16x32_bf16(al, bh[sx][1], ac1, 0, 0, 0); }
#pragma unroll
            for (int q = 0; q < 4; ++q) { part[(wave * 16 + 4 * fq + q) * 32 + fr] = ac0[q]; part[(wave * 16 + 4 * fq + q) * 32 + 16 + fr] = ac1[q]; }
        }
        __syncthreads();
        {
            const int r = tid >> 5; float lg = br[e];
#pragma unroll
            for (int w = 0; w < 8; ++w) lg += part[(w * 16 + r) * 32 + e];
            float val = lg; float tv[4]; int tix[4];
#pragma unroll
            for (int k = 0; k < 4; ++k) {
                float bv = val; int bi = e;
#pragma unroll
                for (int off = 16; off >= 1; off >>= 1) { const float ov = __shfl_xor(bv, off); const int oi = __shfl_xor(bi, off); if (ov > bv || (ov == bv && oi < bi)) { bv = ov; bi = oi; } }
                tv[k] = bv; tix[k] = bi; if (e == bi) val = -INFINITY;
            }
            const float e1 = __expf(tv[1] - tv[0]), e2 = __expf(tv[2] - tv[0]), e3 = __expf(tv[3] - tv[0]); const float inv = 1.f / (1.f + e1 + e2 + e3);
            if (e < 4) { const int k = e; const int ek = k == 0 ? tix[0] : k == 1 ? tix[1] : k == 2 ? tix[2] : tix[3]; const float wk = (k == 0 ? 1.f : k == 1 ? e1 : k == 2 ? e2 : e3) * inv;
                const unsigned pl = __hip_atomic_fetch_add(hist + ek, 1u, __ATOMIC_RELAXED, __HIP_MEMORY_SCOPE_WORKGROUP); const int sidx = (pass * 16 + r) * 4 + k; sle[sidx] = (unsigned short)ek; slp[sidx] = (unsigned short)pl; slw[sidx] = wk; }
        }
    }
    __syncthreads();
    if (tid < 32) basep[tid] = __hip_atomic_fetch_add(cnt + tid, hist[tid], __ATOMIC_RELAXED, __HIP_MEMORY_SCOPE_AGENT);
    __syncthreads();
    { const int ek = sle[tid]; const size_t li = (size_t)ek * LCAP + basep[ek] + slp[tid]; GST(int, list + li) = rowbase * 4 + tid; GST(float, listw + li) = slw[tid]; }
    __syncthreads();
#undef P5_ATT_DMA
}
struct P8Par { const float* x; const float2* st0; const float2* st1; const bf16_t* att; const float* g0; const float* b0; const float* g1; const float* b1; const float* g2; const float* b2; };
struct P8Row { uint2 av[4], xv[4]; int sq[4][4]; float2 s1; };
__device__ __forceinline__ void p8_load(P8Row& R, const char* xb0, const char* ab0, const char* sb0, const float2* st1, int row, unsigned lo8, unsigned lo4) {
    const char* xb = xb0 + (size_t)row * (D * 2); const char* ab = ab0 + (size_t)row * (D * 2); const char* sb = sb0 + (size_t)row * (4 * D);
    R.s1 = st1[row];
#pragma unroll
    for (int j = 0; j < 4; ++j) { const u32x2 a2 = GLD(u32x2, ab + lo8 + j * 512), x2 = GLD(u32x2, xb + lo8 + j * 512); R.av[j].x = a2[0]; R.av[j].y = a2[1]; R.xv[j].x = x2[0]; R.xv[j].y = x2[1];
#pragma unroll
        for (int k = 0; k < 4; ++k) R.sq[j][k] = GLD(int, sb + lo4 + k * D + j * 256); }
}
__device__ __forceinline__ void p8_compute(const P8Row& R, float* out, const LAS float* lnp, int row, unsigned lx) {
    float4 v[4]; char* ob = (char*)out + (size_t)row * (D * 4); float s = 0.f;
#pragma unroll
    for (int j = 0; j < 4; ++j) { const unsigned c = lx + j * 1024;
        { const uint2 xw = R.xv[j]; const uint2 aw = R.av[j];
          v[j].x = fmaf(bflo(xw.x), ALPHA, bflo(aw.x)); v[j].y = fmaf(bfhi(xw.x), ALPHA, bfhi(aw.x)); v[j].z = fmaf(bflo(xw.y), ALPHA, bflo(aw.y)); v[j].w = fmaf(bfhi(xw.y), ALPHA, bfhi(aw.y)); }
        { const f32x4 gg = *(const LAS f32x4*)((const LAS char*)lnp + c), bb = *(const LAS f32x4*)((const LAS char*)lnp + 4096 + c);
          v[j].x = ((v[j].x - R.s1.x) * R.s1.y * gg[0] + bb[0]) * ALPHA; v[j].y = ((v[j].y - R.s1.x) * R.s1.y * gg[1] + bb[1]) * ALPHA;
          v[j].z = ((v[j].z - R.s1.x) * R.s1.y * gg[2] + bb[2]) * ALPHA; v[j].w = ((v[j].w - R.s1.x) * R.s1.y * gg[3] + bb[3]) * ALPHA; }
#pragma unroll
        for (int k = 0; k < 4; ++k) { const f32x2 lo = __builtin_amdgcn_cvt_pk_f32_fp8(R.sq[j][k], false), hi = __builtin_amdgcn_cvt_pk_f32_fp8(R.sq[j][k], true);
            v[j].x = fmaf(lo[0], S8SI, v[j].x); v[j].y = fmaf(lo[1], S8SI, v[j].y); v[j].z = fmaf(hi[0], S8SI, v[j].z); v[j].w = fmaf(hi[1], S8SI, v[j].w); }
        s += (v[j].x + v[j].y) + (v[j].z + v[j].w); }
    const float mean = wave_sum(s) * (1.f / D); float s2 = 0.f;
#pragma unroll
    for (int j = 0; j < 4; ++j) { v[j].x -= mean; v[j].y -= mean; v[j].z -= mean; v[j].w -= mean; s2 += (v[j].x * v[j].x + v[j].y * v[j].y) + (v[j].z * v[j].z + v[j].w * v[j].w); }
    const float rstd = rsqrtf(wave_sum(s2) * (1.f / D) + LN_EPS);
#pragma unroll
    for (int j = 0; j < 4; ++j) {
        const unsigned c = lx + j * 1024; const f32x4 gg = *(const LAS f32x4*)((const LAS char*)lnp + 8192 + c), bb = *(const LAS f32x4*)((const LAS char*)lnp + 12288 + c);
        GST(f32x4, ob + c) = (f32x4){v[j].x * rstd * gg[0] + bb[0], v[j].y * rstd * gg[1] + bb[1], v[j].z * rstd * gg[2] + bb[2], v[j].w * rstd * gg[3] + bb[3]};
    }
}
__device__ __forceinline__ void p8_stream(float* out, const bf16_t* slot, const P8Par& P, const LAS float* lnp, int row0, int stride, int lane) {
    const unsigned lo16 = (unsigned)lane * 16u, lo8 = (unsigned)lane * 8u, lo4 = (unsigned)lane * 4u;
    const char* xb0 = (const char*)P.x; const char* ab0 = (const char*)P.att; const char* sb0 = (const char*)slot;
    P8Row A, B; int row = row0; if (row >= NTOK) return;
    p8_load(A, xb0, ab0, sb0, P.st1, row, lo8, lo4);
    for (;;) {
        asm volatile("" : "+s"(xb0), "+s"(ab0), "+s"(sb0));
        unsigned lx = lo16; asm volatile("" : "+v"(lx));
        const int r1 = row + stride; const bool h1 = r1 < NTOK; if (h1) p8_load(B, xb0, ab0, sb0, P.st1, r1, lo8, lo4);
        p8_compute(A, out, lnp, row, lx); if (!h1) break;
        const int r2 = r1 + stride; const bool h2 = r2 < NTOK; if (h2) p8_load(A, xb0, ab0, sb0, P.st1, r2, lo8, lo4);
        p8_compute(B, out, lnp, r1, lx); if (!h2) break;
        row = r2;
    }
}

#define PH_LOCALS \
    int tid = threadIdx.x; asm volatile("" : "+v"(tid)); const int lane = tid & 63, wave = __builtin_amdgcn_readfirstlane(tid >> 6); (void)lane; (void)wave; \
    unsigned char* ws = args.ws; asm volatile("" : "+s"(ws)); \
    const float* x = args.in[0]; (void)x; \
    bf16_t* xn = (bf16_t*)(ws + WS_XN); bf16_t* proj = (bf16_t*)(ws + WS_PROJ); (void)xn; (void)proj; \
    bf16_t* win_t = (bf16_t*)(ws + WS_WIN); bf16_t* wa_t = (bf16_t*)(ws + WS_WA); bf16_t* wb_t = (bf16_t*)(ws + WS_WB); bf16_t* wout_t = (bf16_t*)(ws + WS_WOUT); (void)win_t; (void)wa_t; (void)wb_t; (void)wout_t; \
    bf16_t* wei_t = (bf16_t*)(ws + WS_WEI); bf16_t* weo_t = (bf16_t*)(ws + WS_WEO); (void)wei_t; (void)weo_t; \
    bf16_t* outab = (bf16_t*)(ws + WS_OUTAB); bf16_t* merged = (bf16_t*)(ws + WS_MERGED); bf16_t* slotb = (bf16_t*)(ws + WS_SLOT); bf16_t* abuf = proj; bf16_t* h1b = xn; (void)outab; (void)merged; (void)slotb; (void)abuf; (void)h1b; \
    int* topi = (int*)(ws + WS_TOPI); float* topw = (float*)(ws + WS_TOPW); int* list = (int*)(ws + WS_LIST); (void)topi; (void)topw; (void)list; \
    gu32* ctl = (gu32*)(ws + WS_CTL); (void)ctl; \
    LAS int* tt = (LAS int*)(lds + TTAB_OFF); LAS unsigned* toktab = (LAS unsigned*)(lds + TOKTAB_OFF); (void)tt; (void)toktab;

__global__ void __launch_bounds__(NWAVES * 64, 2) mega(Args args) {
    extern __shared__ __attribute__((aligned(16))) unsigned char lds_raw[];
    LAS unsigned char* lds = (LAS unsigned char*)lds_raw;
    volatile LAS unsigned* MISC = (volatile LAS unsigned*)(lds + MISC_OFF);
    const int tid = threadIdx.x, lane = tid & 63, wave = __builtin_amdgcn_readfirstlane(tid >> 6);
    const int G = gridDim.x; const int bx = blockIdx.x; const int vcu = (G % 8 == 0) ? (bx % 8) * (G / 8) + bx / 8 : bx;
    unsigned char* ws = args.ws;
    gu32* ctl = (gu32*)(ws + WS_CTL);
    if (tid < 64) MISC[tid] = 0u;
    __syncthreads();
    XcdBarrier bar = xcd_barrier_post((unsigned*)ctl + CW_BAR + args.li * XCD_BAR_WORDS, MISC + 8);
    const int lo = args.ph_lo, hi = args.ph_hi;
#ifndef PHMASK
#define PHMASK 0x1ff
#endif
#define IN(k) (((PHMASK >> (k)) & 1) && lo <= (k) && (k) < hi)
#define BOTH(k) (IN(k) && IN((k) + 1))

#if PROBE_PH == 0
    for (int rep_ = 0; rep_ < 2; ++rep_)
#endif
    if (IN(0)) {
        PH_LOCALS
        LAS float* scr = (LAS float*)(lds + RING_OFF + wave * 16640);
        constexpr int I_IN = 16 * 80, I_A = 8 * 16, I_OUT = 16 * 16, I_EI = 16 * 32, I_EO = 16 * 16;
        constexpr int NITEMS = I_IN + 2 * I_A + I_OUT;
#define P0_DECODE(it_, sub_, I) do { int r = (it_); \
            if (r < I_IN / 2) { const int kb = 2 * (r / 80) + (sub_), nb = r % 80; I.W = args.in[3]; I.N = INC; I.K = D; I.k0 = 64 * kb; I.n0 = 64 * nb; \
                if (nb < 48) { I.WT = (unsigned char*)win_t; I.rowbase = 64 * nb; I.f8 = 0; } else { I.WT = (unsigned char*)win_t + (size_t)3072 * D * 2; I.rowbase = 64 * nb - 3072; I.f8 = 1; } break; } r -= I_IN / 2; \
            if (r < I_A / 2) { const int kb = 2 * (r / 16) + (sub_), nb = r % 16; I.W = args.in[11]; I.N = D; I.K = 512; I.k0 = 64 * kb; I.n0 = 64 * nb; I.WT = (unsigned char*)wa_t; I.rowbase = 64 * nb; I.f8 = 1; break; } r -= I_A / 2; \
            if (r < I_A / 2) { const int kb = 2 * (r / 16) + (sub_), nb = r % 16; I.W = args.in[12]; I.N = D; I.K = 512; I.k0 = 64 * kb; I.n0 = 64 * nb; I.WT = (unsigned char*)wb_t; I.rowbase = 64 * nb; I.f8 = 1; break; } r -= I_A / 2; \
            if (r < I_OUT / 2) { const int kb = 2 * (r / 16) + (sub_), nb = r % 16; I.W = args.in[13]; I.N = D; I.K = D; I.k0 = 64 * kb; I.n0 = 64 * nb; I.WT = (unsigned char*)wout_t; I.rowbase = 64 * nb; I.f8 = 1; break; } r -= I_OUT / 2; \
            { I.W = args.in[13]; I.N = D; I.K = D; I.k0 = 0; I.n0 = 0; I.WT = (unsigned char*)wout_t; I.rowbase = 0; I.f8 = 1; } } while (0)
        { P0Item ia, ib; f32x4 va[16], vb[16]; int it = vcu + G * wave; constexpr int NSUP = NITEMS / 2; const int NGW = G * NWAVES;
          if (it < NSUP) { P0_DECODE(it, 0, ia); p0_load(ia, va, lane); }
          while (it < NSUP) {
              P0_DECODE(it, 1, ib); p0_load(ib, vb, lane);
              p0_proc(ia, va, scr, lane);
              const bool hn_ = (it + NGW) < NSUP;
              if (hn_) { P0_DECODE(it + NGW, 0, ia); p0_load(ia, va, lane); }
              p0_proc(ib, vb, scr, lane);
              it += NGW;
          } }
#undef P0_DECODE
        for (;;) { unsigned bch = 0u; if (lane == 0) bch = __hip_atomic_fetch_add((LAS unsigned*)(lds + MISC_OFF) + 32, 1u, __ATOMIC_RELAXED, __HIP_MEMORY_SCOPE_WORKGROUP); bch = (unsigned)__builtin_amdgcn_readfirstlane((int)bch);
            const int blk = vcu + (int)(bch >> 5) * G; if (blk >= NTOK / 128) break;
            ln_rows_in<4>(x, args.in[1], args.in[2], xn, (unsigned char*)merged  , blk * 128 + (int)(bch & 31u) * 4, 1, lane); }
        { u32x4* lz = (u32x4*)(ws + WS_LIST); const u32x4 z = {0u, 0u, 0u, 0u}; for (int i = bx * 512 + tid; i < (int)(NE * LCAP * 4 / 16); i += G * 512) GST(u32x4, lz + i) = z; }
        if (BOTH(0)) xcd_barrier(bar);
    }
#if PROBE_PH == 1
    for (int rep_ = 0; rep_ < 2; ++rep_)
#endif
    if (IN(1)) {
        PH_LOCALS
        { SchedDense S; S.go.init(NTOK / 256, 12, G, bx); S.A = (const char*)xn; S.B = (const char*)win_t; S.tstepA = (size_t)256 * D * 2; S.tstepB = (size_t)256 * D * 2; S.pn_off = 0;
          EpiProj E{proj, (int*)(ctl + CW_NRM)};
          pg::gemm_phase<EpiProj, SchedDense, false>(lds + RING_OFF, nullptr, nullptr, D, D * 2, D * 2, S, E); }
        { SchedDense S; S.go.init(NTOK / 256, 8, G, bx); S.A = (const char*)merged; S.B = (const char*)win_t + (size_t)3072 * D * 2; S.tstepA = (size_t)256 * D; S.tstepB = (size_t)256 * D; S.pn_off = 12;
          EpiGates E{ws + WS_GATES, args.in[4], W8SI};
          pg::gemm_phase<EpiGates, SchedDense, false, true>(lds + RING_OFF, toktab, nullptr, D / 2, D, D, S, E); }
        if (BOTH(1)) xcd_barrier(bar);
    }
#if PROBE_PH == 2
    for (int rep_ = 0; rep_ < 2; ++rep_)
#endif
    if (IN(2)) {
        PH_LOCALS
        bf16_t* outab_ = outab; float* oc0 = (float*)(ws + WS_SLOT);
        { LAS float* bt = (LAS float*)(lds + att::L_TAB); const float* relb = args.in[10]; for (int i = tid; i < 8 * 257; i += NWAVES * 64) bt[i] = relb[i] * LOG2E; }
        if (wave == 0) { for (int hh = 0; hh < 8; ++hh) { float m_ = -1e30f; for (int i = lane; i < 257; i += 64) m_ = fmaxf(m_, args.in[10][hh * 257 + i] * LOG2E); m_ = wave_max(m_); if (lane == 0) ((LAS float*)(lds + 100864))[8 + hh] = m_ + 1e-6f; } }
        { const float lam_ = __expf(wave_sum(args.in[5][lane] * args.in[6][lane])) - __expf(wave_sum(args.in[7][lane] * args.in[8][lane])) + LAM_INIT; if (tid == 0) ((LAS float*)(lds + 100864))[3] = lam_; }
        __syncthreads();
        const int* nrmsq = (const int*)(ctl + CW_NRM);
#define NRM(i) (sqrtf(2.f * __uint_as_float((unsigned)nrmsq[(i)])) * 1.01f)
        constexpr int C_EI = 16 * 32 / 2, C_EO = 16 * 16 / 2, C_PER_WG = (NE * (C_EI + C_EO) + 255) / 256;
        bool cdone = false;
#define CONV_DECODE(si_, sub_, I) do { int r = (si_); \
            if (r < NE * C_EI) { const int e = r / C_EI, q = r % C_EI, kb = 2 * (q / 32) + (sub_), nb = q % 32; const int n0 = 64 * nb, j0 = n0 & 1023;     \
                I.W = args.in[18] + (size_t)e * D * 2 * DFF; I.N = 2 * DFF; I.K = D; I.k0 = 64 * kb; I.n0 = n0; I.WT = (unsigned char*)wei_t + (size_t)e * 2 * DFF * D; I.rowbase = 256 * (j0 >> 7) + (n0 >= 1024 ? 128 : 0) + (j0 & 127); I.f8 = 1; break; } r -= NE * C_EI; \
            { const int e = r / C_EO, q = r % C_EO, kb = 2 * (q / 16) + (sub_), nb = q % 16; I.W = args.in[20] + (size_t)e * DFF * D; I.N = D; I.K = DFF; I.k0 = 64 * kb; I.n0 = 64 * nb; I.WT = (unsigned char*)weo_t + (size_t)e * D * DFF; I.rowbase = 64 * nb; I.f8 = 1; } } while (0)
#define CONV_ROUNDS(nr_) do { int tc_ = threadIdx.x; asm volatile("" : "+v"(tc_)); const int lc_ = tc_ & 63, wc_ = __builtin_amdgcn_readfirstlane(tc_ >> 6); \
        for (int rr_ = 0; rr_ < (nr_) && !cdone; ++rr_) { \
            if (tc_ == 0) qbox[5] = (int)__hip_atomic_fetch_add(ctl + CW_CQ, 7u, __ATOMIC_RELAXED, __HIP_MEMORY_SCOPE_AGENT); \
            __syncthreads(); const int sb_ = __builtin_amdgcn_readfirstlane(qbox[5]); __syncthreads(); \
            if (sb_ >= NE * (C_EI + C_EO)) { cdone = true; break; } \
            const int si_ = sb_ + wc_; \
            if (wc_ < 7 && si_ < NE * (C_EI + C_EO)) { P0Item ia_, ib_; f32x4 va_[16], vb_[16]; LAS float* scr_ = (LAS float*)(lds + (wc_ < 5 ? wc_ * 16640 : (wc_ == 5 ? 102400 : CONV_SCR6))); \
                CONV_DECODE(si_, 0, ia_); p0_load(ia_, va_, lc_); CONV_DECODE(si_, 1, ib_); p0_load(ib_, vb_, lc_); p0_proc(ia_, va_, scr_, lc_); p0_proc(ib_, vb_, scr_, lc_); } } } while (0)
        LAS int* order = (LAS int*)(lds + 101376);
        LAS int* qbox = (LAS int*)(lds + 100864);
        const int x0 = (G % 8 == 0) ? (bx % 8) : 0;
        for (int kx = 0; kx < 8; ++kx) {
            const int x = (x0 + kx) & 7; const int bq = x >> 1, hA = 2 + (x & 1), hB = (x & 1) ? 0 : 1;
            __syncthreads();
            constexpr int SQ = ATT_SPLIT_QB, NEA = SQ + 2 * (32 - SQ), NENT = NEA + 32;
#define ENT_COST(e, out) do { const int e_ = (e); if (e_ < SQ) out = 2 * (4 * e_ + 4); else if (e_ < NEA) out = 4 * (SQ + ((e_ - SQ) >> 1)) + 4; else { const int capB = hB == 0 ? 16 : 44; out = 2 * min(4 * (e_ - NEA) + 4, capB); } } while (0)
            if (tid < NENT) { int cu; ENT_COST(tid, cu); int rank = 0;
                for (int v = 0; v < NENT; ++v) { int cv; ENT_COST(v, cv); rank += (cv > cu || (cv == cu && v < tid)) ? 1 : 0; }
                order[rank] = tid; }
#undef ENT_COST
            __syncthreads();
            for (;;) {
                { int t0 = threadIdx.x; asm volatile("" : "+v"(t0)); if (t0 == 0) qbox[0] = (int)__hip_atomic_fetch_add(ctl + CW_Q + 64 * x, 1u, __ATOMIC_RELAXED, __HIP_MEMORY_SCOPE_AGENT); }
                __syncthreads();
                const int qi = __builtin_amdgcn_readfirstlane(qbox[0]);
                if (qi >= NENT + 128) break;
                if (qi < NENT) {
                    const int e = __builtin_amdgcn_readfirstlane(order[qi]); const int b_ = bq;
                    const int h_ = e < NEA ? hA : hB, qb_ = e < SQ ? e : (e < NEA ? SQ + ((e - SQ) >> 1) : e - NEA), cm = (e >= SQ && e < NEA) ? ((e - SQ) & 1) : 2;
                    int tq = threadIdx.x; asm volatile("" : "+v"(tq));
                    if (tq < 2) qbox[1 + tq] = 4 * qb_;
                    __syncthreads();
                    if (tq < 256) { const int c_ = tq >> 7, t = tq & 127; const int bhc = (b_ * 4 + h_) * 2 + c_; const int kn = bhc * 128, qn = (32 + bhc) * 128;
                        const float slope2 = exp2f(-2.f * (float)(h_ + 1)) * LOG2E;
                        const float qmax = fmaxf(fmaxf(NRM(qn + 4 * qb_), NRM(qn + 4 * qb_ + 1)), fmaxf(NRM(qn + 4 * qb_ + 2), NRM(qn + 4 * qb_ + 3)));
                        if (t < 4 * qb_) { const float bound = qmax * NRM(kn + t) - slope2 * (float)(qb_ * 256 - 64 * t - 63);
                            if (!(bound < -152.f)) __hip_atomic_fetch_min(qbox + 1 + c_, t, __ATOMIC_RELAXED, __HIP_MEMORY_SCOPE_WORKGROUP); } }
                    __syncthreads();
                    const int tlo0 = __builtin_amdgcn_readfirstlane(qbox[1]), tlo1 = __builtin_amdgcn_readfirstlane(qbox[2]);
                    if (tq < 2) qbox[6 + tq] = 0;
                    __syncthreads();
                    if (tq < 256) { const int c_ = tq >> 7, t = tq & 127; const int bhc = (b_ * 4 + h_) * 2 + c_; const int tl_ = c_ ? tlo1 : tlo0;
                        if (t >= tl_ && t <= 4 * qb_ + 3) __hip_atomic_fetch_max(qbox + 6 + c_, (int)__float_as_uint(NRM(bhc * 128 + t)), __ATOMIC_RELAXED, __HIP_MEMORY_SCOPE_WORKGROUP); }
                    __syncthreads();
                    const float kmax0 = __uint_as_float((unsigned)__builtin_amdgcn_readfirstlane(qbox[6])), kmax1 = __uint_as_float((unsigned)__builtin_amdgcn_readfirstlane(qbox[7]));
                    const float lam = __builtin_bit_cast(float, __builtin_amdgcn_readfirstlane(qbox[3]));
                    att::unit_a(lds + RING_OFF, proj, oc0, outab_, args.in[9], lam, ctl + CW_AC, qbox, b_, h_, cm, qb_, tlo0, tlo1, kmax0, kmax1);
                } else {
                    const int u = qi - NENT; const int bh = 4 * x + (u >> 5), qb_ = u & 31;
                    { int tq = threadIdx.x; asm volatile("" : "+v"(tq)); if (tq == 0) qbox[6] = 0; __syncthreads();
                      const int tl_ = 4 * qb_ - 8 < 0 ? 0 : 4 * qb_ - 8;
                      if (tq < 128 && tq >= tl_ && tq <= 4 * qb_ + 3) __hip_atomic_fetch_max(qbox + 6, (int)__float_as_uint(NRM((64 + bh) * 128 + tq)), __ATOMIC_RELAXED, __HIP_MEMORY_SCOPE_WORKGROUP);
                      __syncthreads(); }
                    att::unit_b(lds + RING_OFF, proj, outab_, bh >> 3, bh & 7, qb_, __uint_as_float((unsigned)__builtin_amdgcn_readfirstlane(qbox[6])), __builtin_bit_cast(float, __builtin_amdgcn_readfirstlane(qbox[8 + (bh & 7)])));
                }
                __syncthreads();
                CONV_ROUNDS(2);
            }
        }
        __syncthreads();
        CONV_ROUNDS(1 << 20);
        asm volatile("s_waitcnt vmcnt(0)" ::: "memory");
#undef CONV_ROUNDS
#undef CONV_DECODE
#undef NRM
        if (BOTH(2)) xcd_barrier(bar);
    }
#if PROBE_PH == 3
    for (int rep_ = 0; rep_ < 2; ++rep_)
#endif
    if (IN(3)) {
        PH_LOCALS
        SchedMerged S; S.go.init(NTOK / 256, D / 256, G, bx); S.outab = (const char*)outab; S.wa = (const char*)wa_t; S.wb = (const char*)wb_t;
        EpiMerged E{ws + WS_GATES, merged};
        pg::gemm_phase<EpiMerged, SchedMerged, false, true>(lds + RING_OFF, nullptr, nullptr, 256, D, 512, S, E);
        if (BOTH(3)) xcd_barrier(bar);
    }
#if PROBE_PH == 4
    for (int rep_ = 0; rep_ < 2; ++rep_)
#endif
    if (IN(4)) {
        PH_LOCALS
        SchedDense S; S.go.init(NTOK / 256, D / 256, G, bx); S.A = (const char*)merged; S.B = (const char*)wout_t; S.tstepA = (size_t)256 * D; S.tstepB = (size_t)256 * D; S.pn_off = 0;
        EpiY E{outab  };
        pg::gemm_phase<EpiY, SchedDense, false, true>(lds + RING_OFF, nullptr, nullptr, D / 2, D, D, S, E);
        if (BOTH(4)) xcd_barrier(bar);
    }
    if (IN(5)) {
        PH_LOCALS
        for (int rb = bx * 128; rb < NTOK; rb += G * 128) p5_router(lds + RING_OFF, xn, args.in[1], args.in[2], outab, (float2*)(ws + WS_ST1), args.in[14], args.in[15], args.in[16], args.in[17], h1b, (unsigned char*)merged, topi, topw, ctl + CW_CNT, list, (float*)(ws + WS_WA)  , rb, tid, lane, wave);
        if (BOTH(5)) xcd_barrier(bar);
    }
#if PROBE_PH == 6
    for (int rep_ = 0; rep_ < 2; ++rep_)
#endif
    if (IN(6)) {
        PH_LOCALS
        build_tile_table(tt, ctl + CW_CNT, tid);
        const int ntl = __builtin_amdgcn_readfirstlane(tt[2 * MAXT + 32]);
        SchedExpert S; S.go.init(ntl, 8, G, bx); S.tt = tt; S.A = (const char*)merged  ; S.B = (const char*)wei_t; S.bstride_e = (size_t)2 * DFF * D; S.bstride_n = (size_t)256 * D; S.astride_t = 0; S.gatherA = true;
        EpiSwiglu E{args.in[19], abuf};
        pg::gemm_phase<EpiSwiglu, SchedExpert, true, true>(lds + RING_OFF, toktab, list, D / 2, D, D, S, E);
        if (BOTH(6)) xcd_barrier(bar);
    }
#if PROBE_PH == 7
    for (int rep_ = 0; rep_ < 2; ++rep_)
#endif
    if (IN(7)) {
        PH_LOCALS
        if (!IN(6)) build_tile_table(tt, ctl + CW_CNT, tid);
        const int ntl = __builtin_amdgcn_readfirstlane(tt[2 * MAXT + 32]);
        SchedExpert S; S.go.init(ntl, 4, G, bx); S.tt = tt; S.A = (const char*)abuf; S.B = (const char*)weo_t; S.bstride_e = (size_t)D * DFF; S.bstride_n = (size_t)256 * DFF; S.astride_t = (size_t)256 * DFF; S.gatherA = false;
        EpiScatter E{args.in[21], (const float*)(ws + WS_WA), slotb};
        pg::gemm_phase<EpiScatter, SchedExpert, false, true>(lds + RING_OFF, toktab, list, DFF / 2, DFF, DFF, S, E);
        if (BOTH(7)) xcd_barrier(bar);
    }
#if PROBE_PH == 8
    for (int rep_ = 0; rep_ < 2; ++rep_)
#endif
    if (IN(8)) {
        PH_LOCALS
        const int gw = vcu * NWAVES + wave, NGW = G * NWAVES;
        const P8Par PP{(const float*)xn  , (const float2*)(ws + WS_ST0), (const float2*)(ws + WS_ST1), outab, args.in[1], args.in[2], args.in[14], args.in[15], args.in[22], args.in[23]};
        { LAS float* lnp = (LAS float*)(lds + RING_OFF); const float* src = tid < 256 ? (tid < 128 ? args.in[14] : args.in[15]) : (tid < 384 ? args.in[22] : args.in[23]);
          const int a_ = tid >> 7, c8 = (tid & 127) * 8; *(LAS f32x4*)(lnp + a_ * 1024 + c8) = *(const f32x4*)(src + c8); *(LAS f32x4*)(lnp + a_ * 1024 + c8 + 4) = *(const f32x4*)(src + c8 + 4);
          __syncthreads();
          p8_stream(args.out, slotb, PP, lnp, gw, NGW, lane); }
    }
#undef IN
#undef BOTH
}


extern "C" void kernel_launch(void* const* d_in, const int* in_sizes, int n_in, void* d_out, int out_size, void* d_ws, size_t ws_size, hipStream_t stream) {
    if (n_in != 24 || ws_size < WS_END) { fprintf(stderr, "kernel_launch: unexpected n_in %d / ws %zu\n", n_in, ws_size); return; }
    static int grid = 0;
    if (grid == 0) {
        int dev = 0, cus = 0;
        if (hipGetDevice(&dev) != hipSuccess || hipDeviceGetAttribute(&cus, hipDeviceAttributeMultiprocessorCount, dev) != hipSuccess) { grid = -1; return; }
        if (hipFuncSetAttribute((const void*)mega, hipFuncAttributeMaxDynamicSharedMemorySize, LDS_BYTES) != hipSuccess) { fprintf(stderr, "kernel_launch: hipFuncSetAttribute failed\n"); grid = -1; return; }
        grid = cus;
    }
    if (grid < 0) return;
    unsigned char* ws = (unsigned char*)d_ws; float* out = (float*)d_out;
    (void)hipMemsetAsync(ws + WS_CTL, 0, 1 * MiB, stream);
    Args a{}; for (int i = 0; i < 24; ++i) a.in[i] = (const float*)d_in[i]; a.out = out; a.ws = ws;
    a.ph_lo = 0; a.ph_hi = 9; a.li = 0;
    hipLaunchKernelGGL(mega, dim3(grid), dim3(NWAVES * 64), LDS_BYTES, stream, a);
}
```

```cpp
#include <hip/hip_runtime.h>
#include <cstdint>
#include <cstdio>

typedef unsigned short bf16_t;
#ifndef ATT_SPLIT_QB
#define ATT_SPLIT_QB 32
#endif
#ifndef PROBE_PH
#define PROBE_PH -1
#endif

constexpr int NB = 4, SEQ = 8192, D = 1024, NTOK = NB * SEQ, INC = 5120;
constexpr int NE = 32, TOPK = 4, DFF = 1024;
constexpr int LCAP = NTOK;
constexpr int MAXT = NTOK * TOPK / 256 + NE;
constexpr float ALPHA = 1.189207115002721f;
constexpr float LN_EPS = 1e-5f;
constexpr float LOG2E = 1.4426950408889634f;
constexpr float C2 = 0.125f * LOG2E;
constexpr float LAM_INIT = 0.2f;
constexpr float SWA = 1.702f, SWL = 7.0f;

constexpr size_t MiB = 1u << 20;
constexpr size_t WS_CTL = 0;
constexpr size_t WS_TOPI = 1 * MiB;
constexpr size_t WS_TOPW = 2 * MiB;
constexpr size_t WS_LIST = 3 * MiB;
constexpr size_t WS_ST0 = 7 * MiB;
constexpr size_t WS_ST1 = 7 * MiB + 256 * 1024;
constexpr size_t WS_TINFO = 7 * MiB + 512 * 1024;
constexpr size_t WS_WIN = 8 * MiB;
constexpr size_t WS_WA = 18 * MiB, WS_WB = 19 * MiB, WS_WOUT = 20 * MiB;
constexpr size_t WS_WEI = 32 * MiB;
constexpr size_t WS_WEO = 160 * MiB;
constexpr size_t WS_XN = 224 * MiB;
constexpr size_t WS_PROJ = 288 * MiB;
constexpr size_t WS_OUTAB = 608 * MiB;
constexpr size_t WS_MERGED = 672 * MiB;
constexpr size_t WS_SLOT = 736 * MiB;
constexpr size_t WS_VBLK = 864 * MiB;
constexpr size_t WS_KBLK = 928 * MiB;
constexpr size_t WS_GATES = 800 * MiB;
constexpr size_t WS_END = 992 * MiB;
constexpr int CW_CNT = 64;
constexpr int CW_Q = 128;
constexpr int CW_CQ = 704;
constexpr int CW_NRM = 8192;
constexpr int CW_AC = 1024;

__device__ __forceinline__ float bf2f(unsigned v) { return __uint_as_float(v << 16); }
__device__ __forceinline__ unsigned f2bf(float f) { unsigned u = __float_as_uint(f); return (u + 0x7fffu + ((u >> 16) & 1u)) >> 16; }
__device__ __forceinline__ float wave_sum(float v) {
    v += __int_as_float(__builtin_amdgcn_update_dpp(0, __float_as_int(v), 0xB1, 0xf, 0xf, true));
    v += __int_as_float(__builtin_amdgcn_update_dpp(0, __float_as_int(v), 0x4E, 0xf, 0xf, true));
    v += __int_as_float(__builtin_amdgcn_update_dpp(0, __float_as_int(v), 0x141, 0xf, 0xf, true));
    v += __int_as_float(__builtin_amdgcn_update_dpp(0, __float_as_int(v), 0x140, 0xf, 0xf, true));
    { const auto r = __builtin_amdgcn_permlane16_swap(__float_as_uint(v), __float_as_uint(v), false, false); v = __uint_as_float(r[0]) + __uint_as_float(r[1]); }
    { const auto r = __builtin_amdgcn_permlane32_swap(__float_as_uint(v), __float_as_uint(v), false, false); v = __uint_as_float(r[0]) + __uint_as_float(r[1]); }
    return v;
}
__device__ __forceinline__ float wave_max(float v) {
#pragma unroll
    for (int o = 1; o < 64; o <<= 1) v = fmaxf(v, __shfl_xor(v, o));
    return v;
}

#define LAS __attribute__((address_space(3)))
#define GAS __attribute__((address_space(1)))
typedef short bf16x8 __attribute__((ext_vector_type(8)));
typedef float f32x4 __attribute__((ext_vector_type(4)));
typedef float f32x2 __attribute__((ext_vector_type(2)));
typedef unsigned u32x4 __attribute__((ext_vector_type(4)));
typedef unsigned u32x2 __attribute__((ext_vector_type(2)));
#define GAS __attribute__((address_space(1)))
#define GST(T, p) (*(GAS T*)(p))
#define GLD(T, p) (*(const GAS T*)(p))
#define GLD_NT(T, p) __builtin_nontemporal_load((const GAS T*)(p))
#define GST_NT(T, p, v) __builtin_nontemporal_store((T)(v), (GAS T*)(p))
typedef int v8i32_t __attribute__((ext_vector_type(8)));
typedef int v4i32_t __attribute__((ext_vector_type(4)));
typedef GAS unsigned gu32;

namespace pg {
constexpr int BM = 256, BK = 64, HALF = 128, HTB = HALF * BK * 2, STAGE_BYTES = 8 * HTB, NXCD = 8, WGM = 8;
__host__ __device__ __forceinline__ int lds_byte(int r, int c) { const int st = (r >> 4) * 2 + (c >> 5), rr = r & 15, cc = c & 31, ob = rr * 64 + cc * 2; return st * 1024 + (ob ^ (((ob >> 9) & 1) << 5)); }
__host__ __device__ __forceinline__ void stage_rc(int b, int& R, int& C) { const int st = b / 1024, sb = b % 1024, swz = sb ^ (((sb >> 9) & 1) << 5); R = (st >> 1) * 16 + swz / 64; C = (st & 1) * 32 + (swz % 64) / 2; }
__host__ __device__ __forceinline__ int perm32(int rho) { const int n = rho >> 4, i = rho & 15; return 8 * (i >> 2) + 4 * n + (i & 3); }
__device__ __forceinline__ unsigned cvt_pk_bf16(float lo, float hi) { unsigned r; asm volatile("v_cvt_pk_bf16_f32 %0, %1, %2" : "=v"(r) : "v"(lo), "v"(hi)); return r; }

struct Unit { const char* A; const char* B; int pm, pn, x0, x1, x2, x3; };

struct GridOrder {
    int nM, nN, nwg, G, c;
    __device__ void init(int nM_, int nN_, int G_, int c_) { nM = nM_; nN = nN_; nwg = nM * nN; G = G_; c = c_; }
    __device__ bool tile(int i, int& pm, int& pn) const {
        const long L = (long)i * G + c; if (L >= nwg) return false;
        int wgid = (int)L; { const int q = nwg / NXCD, r = nwg % NXCD, xcd = wgid % NXCD, off = wgid / NXCD; wgid = (xcd < r ? xcd * (q + 1) : r * (q + 1) + (xcd - r) * q) + off; }
        const int nig = WGM * nN, gid = wgid / nig, fm = gid * WGM, gsz = (nM - fm) < WGM ? (nM - fm) : WGM;
        pm = fm + ((wgid % nig) % gsz); pn = (wgid % nig) / gsz; return true;
    }
};

template <class Epi, class Sched, bool GATHER, bool F8 = false>
__device__ __forceinline__ void gemm_phase(LAS unsigned char* lds, LAS unsigned* tok_tab, const int* list, const int K, const unsigned lda, const unsigned ldb, const Sched& S, const Epi& E, const unsigned char* wsb) {
    const __amdgpu_buffer_rsrc_t rs = __builtin_amdgcn_make_buffer_rsrc((void*)wsb, (short)0, 0x7fffffff, 0x00020000);
#define PG_DMA(gptr_, voff_, ldst_) __builtin_amdgcn_raw_ptr_buffer_load_lds(rs, (LAS unsigned*)(ldst_), 16, (int)(voff_), (int)(unsigned)((const char*)(gptr_) - (const char*)wsb), 0, 0)
    const int tid = threadIdx.x, wid = __builtin_amdgcn_readfirstlane(tid >> 6), lane = tid & 63, wr = wid >> 2, wc = wid & 3, fr = lane & 15, fq = lane >> 4;
    const int nt = K / BK;
    unsigned voffA[2], voffB[2]; int R0g = 0; unsigned C2g = 0;
#pragma unroll
    for (int i = 0; i < 2; ++i) { int R, C; stage_rc(tid * 16 + i * 8192, R, C); const int Rb = Epi::PERM ? ((R & ~31) + perm32(R & 31)) : R;
        voffA[i] = (unsigned)R * lda + (unsigned)C * 2u; voffB[i] = (unsigned)Rb * ldb + (unsigned)C * 2u; if (i == 0) { R0g = R; C2g = (unsigned)C * 2u; } }
#define PG_TOKDMA(slot, lidx) do { if (wid == 0) __builtin_amdgcn_global_load_lds((const unsigned*)(list + (lidx) + lane * 4), (LAS unsigned*)(tok_tab + (slot) * 256), 16, 0, 0); } while (0)
#define PG_STAGE_G(bufoff, gbase, slot, h) do { const LAS unsigned* _t = tok_tab + (slot) * 256 + (h) * 128 + R0g; const unsigned _t0 = _t[0] >> 2, _t1 = _t[64] >> 2; \
        PG_DMA(gbase, _t0 * lda + C2g, lds + (bufoff) + ldsw); \
        PG_DMA(gbase, _t1 * lda + C2g, lds + (bufoff) + ldsw + 8192); } while (0)
    unsigned goff[2][2] = {{0u, 0u}, {0u, 0u}};
#define PG_GOFF(slot) do { _Pragma("unroll") for (int h_ = 0; h_ < 2; ++h_) { const LAS unsigned* _t = tok_tab + (slot) * 256 + h_ * 128 + R0g; goff[h_][0] = (_t[0] >> 2) * lda + C2g; goff[h_][1] = (_t[64] >> 2) * lda + C2g; } } while (0)
#define PG_STAGE_GR(bufoff, gbase, h) do { \
        PG_DMA(gbase, goff[h][0], lds + (bufoff) + ldsw); \
        PG_DMA(gbase, goff[h][1], lds + (bufoff) + ldsw + 8192); } while (0)
#define PG_STAGE_A(bufoff, gbase, h, slot) do { if constexpr (GATHER) { if ((slot) == (ui & 1)) PG_STAGE_GR(bufoff, gbase, h); else PG_STAGE_G(bufoff, gbase, slot, h); } else { PG_STAGE(bufoff, (gbase) + (h) * hstepA, voffA); } } while (0)
    const size_t kstep = (size_t)(BK * 2);
    const size_t hstepA = (size_t)HALF * lda, hstepB = (size_t)HALF * ldb;
    const unsigned ldsw = (unsigned)wid * 1024u;
    const int aoff = lds_byte(wr * 64 + fr, fq * 8);
    const int boff = lds_byte(wc * 32 + fr, fq * 8);
    constexpr int KOFF = 1024;
#define PG_SA(b, h) (((b) * 2 + (h)) * HTB)
#define PG_SB(b, h) ((4 + (b) * 2 + (h)) * HTB)
#define PG_STAGE(bufoff, gbase, voff) do { _Pragma("unroll") for (int _i = 0; _i < 2; ++_i) \
        PG_DMA(gbase, (voff)[_i], lds + (bufoff) + ldsw + _i * 8192); } while (0)
#define PG_LDA(dst, b, h) do { _Pragma("unroll") for (int m = 0; m < 4; ++m) _Pragma("unroll") for (int k = 0; k < 2; ++k) dst[m][k] = *(const LAS bf16x8*)(lds + PG_SA(b, h) + aoff + m * 2048 + k * KOFF); } while (0)
#define PG_LDB(dst, b, h) do { _Pragma("unroll") for (int n = 0; n < 2; ++n) _Pragma("unroll") for (int k = 0; k < 2; ++k) dst[n][k] = *(const LAS bf16x8*)(lds + PG_SB(b, h) + boff + n * 2048 + k * KOFF); } while (0)
#define PG_RD8(p_) __builtin_shufflevector(*(const LAS v4i32_t*)(p_), *(const LAS v4i32_t*)((p_) + KOFF), 0, 1, 2, 3, 4, 5, 6, 7)
#define PG_LDA8(dst, b, h) do { _Pragma("unroll") for (int m = 0; m < 4; ++m) dst[m] = PG_RD8(lds + PG_SA(b, h) + aoff + m * 2048); } while (0)
#define PG_LDB8(dst, b, h) do { _Pragma("unroll") for (int n = 0; n < 2; ++n) dst[n] = PG_RD8(lds + PG_SB(b, h) + boff + n * 2048); } while (0)
#define PG_MMA8(ai, bj, At, Bt) do { __builtin_amdgcn_s_setprio(1); _Pragma("unroll") for (int m = 0; m < 4; ++m) _Pragma("unroll") for (int n = 0; n < 2; ++n) \
        asm volatile("v_mfma_scale_f32_16x16x128_f8f6f4 %0, %1, %2, %0, %3, %3 op_sel_hi:[0,0,0]" : "+v"(acc[ai][bj][m][n]) : "v"(Bt[n]), "v"(At[m]), "v"(sc8)); __builtin_amdgcn_s_setprio(0); } while (0)
#define PG_MMA(ai, bj, At, Bt) do { __builtin_amdgcn_s_setprio(1); _Pragma("unroll") for (int m = 0; m < 4; ++m) _Pragma("unroll") for (int n = 0; n < 2; ++n) _Pragma("unroll") for (int k = 0; k < 2; ++k) \
        acc[ai][bj][m][n] = __builtin_amdgcn_mfma_f32_16x16x32_bf16(Bt[n][k], At[m][k], acc[ai][bj][m][n], 0, 0, 0); __builtin_amdgcn_s_setprio(0); } while (0)
#define PG_WAIT_V(n) asm volatile("s_waitcnt vmcnt(" #n ")" ::: "memory")
#define PG_WAIT_L(n) asm volatile("s_waitcnt lgkmcnt(" #n ")" ::: "memory")
#define PG_BAR __builtin_amdgcn_s_barrier()
#define PG_SCHED __builtin_amdgcn_sched_barrier(0)
    Unit cur, nxt; int ui = 0;
    if (!S.next(0, cur)) return;
    f32x4 acc[2][2][4][2];
#pragma unroll
    for (int a = 0; a < 2; ++a)
#pragma unroll
        for (int b = 0; b < 2; ++b)
#pragma unroll
            for (int m = 0; m < 4; ++m)
#pragma unroll
                for (int n = 0; n < 2; ++n) acc[a][b][m][n] = (f32x4){0.f, 0.f, 0.f, 0.f};
    bf16x8 At[4][2], B0[2][2], B1[2][2]; v8i32_t At8[4], B08[2], B18[2];
    const int sc8 = 0x7F7F7F7F;
    const char* cA = cur.A; const char* cB = cur.B;
    if constexpr (GATHER) { PG_TOKDMA(0, cur.x3); PG_WAIT_V(0); PG_BAR; PG_GOFF(0); }
#define PG_ROWDMA(slot, lidx) do { if (wid == 0) { __builtin_amdgcn_global_load_lds((const unsigned*)(list + (lidx) + lane * 4), (LAS unsigned*)(tok_tab + (slot) * 256), 16, 0, 0); \
        __builtin_amdgcn_global_load_lds((const unsigned*)(E.listw + (lidx) + lane * 4), (LAS unsigned*)(tok_tab + 512 + (slot) * 256), 16, 0, 0); } } while (0)
    if constexpr (Epi::ROWINFO) { PG_ROWDMA(0, cur.x3); }
#define PG_BIASDMA(slot, un) do { if (wid == 0) __builtin_amdgcn_global_load_lds((const unsigned*)E.bias_src(un, lane), (LAS unsigned*)(tok_tab + 1024 + (slot) * 256), 16, 0, 0); } while (0)
    if constexpr (Epi::BIASLDS) { PG_BIASDMA(0, cur); }
    PG_STAGE(PG_SB(0, 0), cB, voffB); PG_STAGE(PG_SB(0, 1), cB + hstepB, voffB); PG_STAGE_A(PG_SA(0, 0), cA, 0, 0); PG_STAGE_A(PG_SA(0, 1), cA, 1, 0);
    if (wr == 1) PG_BAR;
    PG_WAIT_V(2); PG_BAR;
    PG_STAGE(PG_SB(1, 0), cB + kstep, voffB); PG_STAGE_A(PG_SA(1, 0), cA + kstep, 0, 0); PG_STAGE(PG_SB(1, 1), cB + hstepB + kstep, voffB);
    PG_WAIT_V(6); PG_BAR;
    for (;;) {
        const bool has_next = S.next(ui + 1, nxt);
        const char* nA = has_next ? nxt.A : cA; const char* nB = has_next ? nxt.B : cB;
        if constexpr (GATHER) { if (has_next) PG_TOKDMA((ui + 1) & 1, nxt.x3); }
        if constexpr (Epi::ROWINFO) { if (ui > 0) PG_ROWDMA(ui & 1, cur.x3); }
        if constexpr (Epi::BIASLDS) { if (ui > 0) PG_BIASDMA(ui & 1, cur); }
#pragma unroll 1
        for (int t = 0; t < nt; t += 2) {
            const bool last = (t == nt - 2);
            const char* a1 = cA + (size_t)(t + 1) * kstep;
            const char* a2 = last ? nA : cA + (size_t)(t + 2) * kstep; const char* b2 = last ? nB : cB + (size_t)(t + 2) * kstep;
            const char* a3 = a2 + kstep; const char* b3 = b2 + kstep;
            const int sc_ = ui & 1, sn_ = (last && has_next) ? ((ui + 1) & 1) : (ui & 1);
            if constexpr (F8) {
            PG_LDB8(B08, 0, 0); PG_LDB8(B18, 0, 1); PG_SCHED; PG_LDA8(At8, 0, 0); PG_STAGE_A(PG_SA(1, 1), a1, 1, sc_);
            PG_WAIT_V(8); PG_WAIT_L(0); PG_BAR; PG_MMA8(0, 0, At8, B08); PG_MMA8(0, 1, At8, B18); PG_BAR; PG_SCHED;
            PG_LDA8(At8, 0, 1); PG_STAGE(PG_SB(0, 0), b2, voffB); PG_STAGE(PG_SB(0, 1), b2 + hstepB, voffB); PG_STAGE_A(PG_SA(0, 0), a2, 0, sn_);
            PG_WAIT_V(8); PG_WAIT_L(0); PG_BAR; PG_MMA8(1, 0, At8, B08); PG_MMA8(1, 1, At8, B18); PG_BAR; PG_SCHED;
            PG_LDB8(B08, 1, 0); PG_LDB8(B18, 1, 1); PG_SCHED; PG_LDA8(At8, 1, 0); PG_STAGE_A(PG_SA(0, 1), a2, 1, sn_);
            PG_WAIT_V(8); PG_WAIT_L(0); PG_BAR; PG_MMA8(0, 0, At8, B08); PG_MMA8(0, 1, At8, B18); PG_BAR; PG_SCHED;
            PG_LDA8(At8, 1, 1); PG_STAGE(PG_SB(1, 0), b3, voffB); PG_STAGE(PG_SB(1, 1), b3 + hstepB, voffB); PG_STAGE_A(PG_SA(1, 0), a3, 0, sn_);
            PG_WAIT_V(8); PG_WAIT_L(0); PG_BAR; PG_MMA8(1, 0, At8, B08); PG_MMA8(1, 1, At8, B18); PG_BAR; PG_SCHED;
            } else {
            PG_LDB(B0, 0, 0); PG_LDB(B1, 0, 1); PG_SCHED; PG_LDA(At, 0, 0); PG_STAGE_A(PG_SA(1, 1), a1, 1, sc_);
            PG_WAIT_V(8); PG_WAIT_L(0); PG_BAR; PG_MMA(0, 0, At, B0); PG_MMA(0, 1, At, B1); PG_BAR; PG_SCHED;
            PG_LDA(At, 0, 1); PG_STAGE(PG_SB(0, 0), b2, voffB); PG_STAGE(PG_SB(0, 1), b2 + hstepB, voffB); PG_STAGE_A(PG_SA(0, 0), a2, 0, sn_);
            PG_WAIT_V(8); PG_WAIT_L(0); PG_BAR; PG_MMA(1, 0, At, B0); PG_MMA(1, 1, At, B1); PG_BAR; PG_SCHED;
            PG_LDB(B0, 1, 0); PG_LDB(B1, 1, 1); PG_SCHED; PG_LDA(At, 1, 0); PG_STAGE_A(PG_SA(0, 1), a2, 1, sn_);
            PG_WAIT_V(8); PG_WAIT_L(0); PG_BAR; PG_MMA(0, 0, At, B0); PG_MMA(0, 1, At, B1); PG_BAR; PG_SCHED;
            PG_LDA(At, 1, 1); PG_STAGE(PG_SB(1, 0), b3, voffB); PG_STAGE(PG_SB(1, 1), b3 + hstepB, voffB); PG_STAGE_A(PG_SA(1, 0), a3, 0, sn_);
            PG_WAIT_V(8); PG_WAIT_L(0); PG_BAR; PG_MMA(1, 0, At, B0); PG_MMA(1, 1, At, B1); PG_BAR; PG_SCHED;
            }
        }
        if (wr == 0) PG_BAR;
        if constexpr (F8) asm volatile("s_nop 15\n\ts_nop 15" ::: "memory");
        int le_ = threadIdx.x & 63; asm volatile("" : "+v"(le_));
        bool keep;
        if constexpr (Epi::ROWINFO) { keep = E(acc, cur, wr, wc, le_ & 15, le_ >> 4, tok_tab + (ui & 1) * 256, (const LAS float*)(tok_tab + 1024 + (ui & 1) * 256));
        }
        else if constexpr (Epi::BIASLDS) keep = E(acc, cur, wr, wc, le_ & 15, le_ >> 4, (const LAS float*)(tok_tab + 1024 + (ui & 1) * 256));
        else keep = E(acc, cur, wr, wc, le_ & 15, le_ >> 4);
        if (!has_next) break;
        if (!keep) {
#pragma unroll
        for (int a = 0; a < 2; ++a)
#pragma unroll
            for (int b = 0; b < 2; ++b)
#pragma unroll
                for (int m = 0; m < 4; ++m)
#pragma unroll
                    for (int n = 0; n < 2; ++n) acc[a][b][m][n] = (f32x4){0.f, 0.f, 0.f, 0.f};
        }
        cur = nxt; cA = nA; cB = nB; ++ui;
        if constexpr (GATHER) { PG_GOFF(ui & 1); }
        if (wr == 1) PG_BAR;
    }
    PG_WAIT_V(0);
    PG_BAR;
#undef PG_TOKDMA
#undef PG_ROWDMA
#undef PG_BIASDMA
#undef PG_STAGE_G
#undef PG_DMA
#undef PG_STAGE_GR
#undef PG_GOFF
#undef PG_STAGE_A
#undef PG_SA
#undef PG_SB
#undef PG_STAGE
#undef PG_LDA
#undef PG_LDB
#undef PG_MMA
#undef PG_MMA8
#undef PG_RD8
#undef PG_LDA8
#undef PG_LDB8
#undef PG_WAIT_V
#undef PG_WAIT_L
#undef PG_BAR
#undef PG_SCHED
}
}

namespace att {
typedef float f32x16 __attribute__((ext_vector_type(16)));
typedef short s16x4 __attribute__((ext_vector_type(4)));
typedef short v4i16_t __attribute__((ext_vector_type(4)));
typedef float f32x2_t __attribute__((ext_vector_type(2))); typedef __bf16 bf16x2_t __attribute__((ext_vector_type(2)));
__device__ __forceinline__ unsigned cvtpk(float lo, float hi) { f32x2_t v = {lo, hi}; bf16x2_t b = __builtin_convertvector(v, bf16x2_t); return __builtin_bit_cast(unsigned, b); }
__device__ __forceinline__ int crow(int r, int hi) { return (r & 3) + 8 * (r >> 2) + 4 * hi; }
constexpr int L_K = 0, L_V = 24576, L_WS = 90112, L_TAB = 92160, L_OST = 0;
constexpr float THR = 8.f;
__device__ __forceinline__ void glds16(const void* gsrc, unsigned lds_dst) {
    asm volatile("s_mov_b32 m0, %1\n\ts_nop 0\n\tglobal_load_lds_dwordx4 %0, off" :: "v"(gsrc), "s"(lds_dst) : "memory", "m0"); }
__device__ __forceinline__ float add1(float a, float b) { float r; asm("v_add_f32 %0, %1, %2" : "=v"(r) : "v"(a), "v"(b)); return r; }
__device__ __forceinline__ float adds1(float s, float b) { float r; asm("v_add_f32 %0, %1, %2" : "=v"(r) : "s"(s), "v"(b)); return r; }
__device__ __forceinline__ float max3f(float a, float b, float c) { float r; asm("v_max3_f32 %0, %1, %2, %3" : "=v"(r) : "v"(a), "v"(b), "v"(c)); return r; }
#if PROBE_PH == 26
__device__ __forceinline__ s16x4 vtr(const LAS unsigned char* p) { s16x4 d_ = __builtin_bit_cast(s16x4, __builtin_amdgcn_ds_read_tr16_b64_v4i16((LAS v4i16_t*)p)); asm volatile("" :: "v"(d_));
    int z_ = 0; asm volatile("" : "+v"(z_)); return __builtin_bit_cast(s16x4, __builtin_amdgcn_ds_read_tr16_b64_v4i16((LAS v4i16_t*)(p + z_))); }
#else
__device__ __forceinline__ s16x4 vtr(const LAS unsigned char* p) { return __builtin_bit_cast(s16x4, __builtin_amdgcn_ds_read_tr16_b64_v4i16((LAS v4i16_t*)p)); }
#endif

template <int DV, int MODE>
__device__ __forceinline__ void attn_pass(LAS unsigned char* lds, const bf16_t* proj, size_t rowb, int qcol, int kcol, int vcol, int q0, int tlo, int thi,
                                          float slope2, const LAS float* btab, float kmax, float bmax, f32x16 (&o)[DV / 32], float (&rli)[16], const char* vbl, const char* kbl) {
    constexpr int NDB = DV / 32, VSLOT = 64 * DV * 2, NVP = DV / 64;
    int tid = threadIdx.x; asm volatile("" : "+v"(tid));
    const int lane = tid & 63, r32 = lane & 31, hi = lane >> 5; const int wid = __builtin_amdgcn_readfirstlane(tid >> 6);
    const int qpos = q0 + 32 * wid + r32, myT = (q0 + 32 * wid) >> 6;
    const char* pjb = (const char*)proj + rowb * (size_t)(INC * 2);
    const unsigned qoff = (unsigned)(qpos * INC + qcol) * 2u;
    bf16x8 qr[4];
#pragma unroll
    for (int d0 = 0; d0 < 4; ++d0) qr[d0] = GLD(bf16x8, pjb + qoff + (d0 * 16 + hi * 8) * 2);
    const unsigned koff = (unsigned)(wid * 1024 + lane * 16); (void)kcol;
    unsigned voff[NVP];
    { int lv_ = lane; asm volatile("" : "+v"(lv_));
#pragma unroll
      for (int j = 0; j < NVP; ++j) voff[j] = (unsigned)((wid + 8 * j) * 1024 + lv_ * 16); }
    (void)vcol;
    const unsigned ldsb = (unsigned)(uintptr_t)lds;
#define ATT_DMA(t, kslot, vslot) do { const char* tb_ = pjb + (size_t)(t) * (64 * INC * 2); \
      _Pragma("unroll") for (int rep_ = 0; rep_ < (PROBE_PH == 22 ? 2 : 1); ++rep_) { \
        glds16(kbl + (size_t)(t) * 8192 + koff, (unsigned)__builtin_amdgcn_readfirstlane(ldsb + L_K + (kslot) * 8192 + wid * 1024)); \
        _Pragma("unroll") for (int _j = 0; _j < NVP; ++_j) \
            glds16(vbl + (size_t)(t) * VSLOT + voff[_j], (unsigned)__builtin_amdgcn_readfirstlane(ldsb + L_V + (vslot) * VSLOT + (wid + 8 * _j) * 1024)); } } while (0)
#define ATT_WAITBAR() do { asm volatile("s_waitcnt vmcnt(0) lgkmcnt(0)" ::: "memory"); __builtin_amdgcn_s_barrier(); asm volatile("" ::: "memory"); } while (0)
    const float s4hi = slope2 * (float)(4 * hi);
    const float a1w = __uint_as_float(__builtin_amdgcn_readfirstlane(__float_as_uint(exp2f(slope2)))), a5w = __uint_as_float(__builtin_amdgcn_readfirstlane(__float_as_uint(exp2f(5.f * slope2))));
#define ATT_CR(r) ((float)(((r) & 3) + 8 * ((r) >> 2)))
    float mhat = 0.f, l = 0.f;
#pragma unroll
    for (int d = 0; d < NDB; ++d) o[d] = f32x16{};
    LAS float* wsf = (LAS float*)(lds + L_WS) + wid * 64;
    const LAS unsigned char* kfb = lds + L_K + hi * 1024 + r32 * 16;
    const LAS unsigned char* vfb = lds + L_V + ((lane >> 4) & 1) * 32 + (lane & 3) * 8 + (4 * hi + ((lane & 15) >> 2)) * 64;
    asm volatile("s_waitcnt lgkmcnt(0)" ::: "memory"); __builtin_amdgcn_s_barrier(); asm volatile("" ::: "memory");
    ATT_DMA(thi, 0, 0);
    if (thi > tlo) ATT_DMA(thi - 1, 1, 1);
    asm volatile("" : "+v"(qr[0]), "+v"(qr[1]), "+v"(qr[2]), "+v"(qr[3]));
    { float ss = 0.f;
#pragma unroll
      for (int d0 = 0; d0 < 4; ++d0)
#pragma unroll
          for (int j = 0; j < 8; ++j) { const float qv = __uint_as_float((unsigned)(unsigned short)qr[d0][j] << 16); ss = fmaf(qv, qv, ss); }
      auto rr = __builtin_amdgcn_permlane32_swap(__float_as_uint(ss), __float_as_uint(ss), false, false); ss = __uint_as_float(rr[0]) + __uint_as_float(rr[1]);
      mhat = sqrtf(ss) * 1.0002f * kmax + bmax; }
    ATT_WAITBAR();
    const bool grpB = (wid >= 4);
    bool pend = false; int pvs = 0;
    u32x4 pw[4];
    int ksl = 0, ksl2 = 2, vsl = 0, vsl2 = 2;
#define ATT_VF(v, ks) ((bf16x8){v[2 * (ks)][0], v[2 * (ks)][1], v[2 * (ks)][2], v[2 * (ks)][3], v[2 * (ks) + 1][0], v[2 * (ks) + 1][1], v[2 * (ks) + 1][2], v[2 * (ks) + 1][3]})
#define ATT_PV(vbase) do { const LAS unsigned char* vb_ = (vbase); s16x4 va[8], vc[8]; \
        _Pragma("unroll") for (int ks = 0; ks < 4; ++ks) { va[2 * ks] = vtr(vb_ + ks * 1024); va[2 * ks + 1] = vtr(vb_ + ks * 1024 + 512); } \
        _Pragma("unroll") for (int d0 = 0; d0 < NDB; d0 += 2) { \
            __builtin_amdgcn_sched_barrier(0); \
            _Pragma("unroll") for (int ks = 0; ks < 4; ++ks) { vc[2 * ks] = vtr(vb_ + (d0 + 1) * 4096 + ks * 1024); vc[2 * ks + 1] = vtr(vb_ + (d0 + 1) * 4096 + ks * 1024 + 512); } \
            _Pragma("unroll") for (int ks = 0; ks < 4; ++ks) o[d0] = __builtin_amdgcn_mfma_f32_32x32x16_bf16(__builtin_bit_cast(bf16x8, pw[ks]), ATT_VF(va, ks), o[d0], 0, 0, 0); \
            __builtin_amdgcn_sched_barrier(0); \
            if (d0 + 2 < NDB) { _Pragma("unroll") for (int ks = 0; ks < 4; ++ks) { va[2 * ks] = vtr(vb_ + (d0 + 2) * 4096 + ks * 1024); va[2 * ks + 1] = vtr(vb_ + (d0 + 2) * 4096 + ks * 1024 + 512); } } \
            _Pragma("unroll") for (int ks = 0; ks < 4; ++ks) o[d0 + 1] = __builtin_amdgcn_mfma_f32_32x32x16_bf16(__builtin_bit_cast(bf16x8, pw[ks]), ATT_VF(vc, ks), o[d0 + 1], 0, 0, 0); } } while (0)
    const float bt0 = (MODE == 1) ? __uint_as_float(__builtin_amdgcn_readfirstlane(__float_as_uint(btab[0]))) : 0.f;
#define ATT_CB(tt) ((MODE == 0) ? (-mhat - slope2 * (float)(qpos - 64 * (tt))) : (((tt) <= myT - 3) ? (bt0 - mhat) : -mhat))
    f32x16 cbn;
    { const float b_ = ATT_CB(thi);
#pragma unroll
      for (int r = 0; r < 16; ++r) cbn[r] = b_; }
    for (int t = thi; t >= tlo; --t) {
        const bool pre = (t - 2 >= tlo);
        if (pre) ATT_DMA(t - 2, ksl2, vsl2);
        if (grpB && pend) { ATT_PV(vfb + pvs * VSLOT); pend = false; }
        const int slot = ksl;
        const bool visible = (MODE == 0) ? (t <= myT) : (t <= myT && t >= myT - 8);
        if (visible) {
            f32x16 p0, p1;
            const LAS unsigned char* kb = kfb + slot * 8192;
            bf16x8 kf[8];
#pragma unroll
            for (int d0 = 0; d0 < 4; ++d0) { kf[2 * d0] = *(const LAS bf16x8*)(kb + d0 * 2048); kf[2 * d0 + 1] = *(const LAS bf16x8*)(kb + d0 * 2048 + 512); }
            __builtin_amdgcn_sched_barrier(0);
            p1 = __builtin_amdgcn_mfma_f32_32x32x16_bf16(kf[1], qr[0], cbn, 0, 0, 0); p0 = __builtin_amdgcn_mfma_f32_32x32x16_bf16(kf[0], qr[0], cbn, 0, 0, 0);
#pragma unroll
            for (int d0 = 1; d0 < 4; ++d0) {
                p0 = __builtin_amdgcn_mfma_f32_32x32x16_bf16(kf[2 * d0], qr[d0], p0, 0, 0, 0); p1 = __builtin_amdgcn_mfma_f32_32x32x16_bf16(kf[2 * d0 + 1], qr[d0], p1, 0, 0, 0); }
            __builtin_amdgcn_sched_barrier(0);
            if (MODE == 0) { if (t == myT) { const float dq = s4hi - slope2 * (float)(qpos & 63), dq1 = dq + 32.f * slope2;
#pragma unroll
                for (int r = 0; r < 16; ++r) { p0[r] -= 2.f * fmaxf(fmaf(slope2, ATT_CR(r), dq), 0.f); p1[r] -= 2.f * fmaxf(fmaf(slope2, ATT_CR(r), dq1), 0.f); } } }
            else { if (t > myT - 3) { const int dbase = 64 * t - qpos + 4 * hi; const LAS float* bx = btab + (dbase + 192);
#pragma unroll
                for (int r = 0; r < 16; ++r) { p0[r] += bx[(r & 3) + 8 * (r >> 2)]; p1[r] += bx[32 + (r & 3) + 8 * (r >> 2)]; } } }
#pragma unroll
#if PROBE_PH == 25
            for (int r = 0; r < 16; ++r) { const float d0_ = __builtin_amdgcn_exp2f(p0[r] + 1.f), d1_ = __builtin_amdgcn_exp2f(p1[r] + 1.f); asm volatile("" :: "v"(d0_), "v"(d1_)); }
#pragma unroll
#endif
            for (int r = 0; r < 16; ++r) { p0[r] = __builtin_amdgcn_exp2f(p0[r]); p1[r] = __builtin_amdgcn_exp2f(p1[r]); }
            if (MODE == 0) { float x = p1[15];
#pragma unroll
                for (int r = 14; r >= 0; --r) x = fmaf(x, (r & 3) == 3 ? a5w : a1w, p1[r]);
                x = fmaf(x, a5w, p0[15]);
#pragma unroll
                for (int r = 14; r >= 0; --r) x = fmaf(x, (r & 3) == 3 ? a5w : a1w, p0[r]);
                l += x; }
            else {
#pragma unroll
                for (int r = 0; r < 16; ++r) { l += p0[r]; l += p1[r]; } }
            pw[0] = (u32x4){cvtpk(p0[0], p0[1]), cvtpk(p0[2], p0[3]), cvtpk(p0[4], p0[5]), cvtpk(p0[6], p0[7])};
            pw[1] = (u32x4){cvtpk(p0[8], p0[9]), cvtpk(p0[10], p0[11]), cvtpk(p0[12], p0[13]), cvtpk(p0[14], p0[15])};
            pw[2] = (u32x4){cvtpk(p1[0], p1[1]), cvtpk(p1[2], p1[3]), cvtpk(p1[4], p1[5]), cvtpk(p1[6], p1[7])};
            pw[3] = (u32x4){cvtpk(p1[8], p1[9]), cvtpk(p1[10], p1[11]), cvtpk(p1[12], p1[13]), cvtpk(p1[14], p1[15])};
            if (!grpB) { ATT_PV(vfb + vsl * VSLOT); }
            else { pend = true; pvs = vsl; }
        }
        { const float b_ = ATT_CB(t - 1);
#pragma unroll
          for (int r = 0; r < 16; ++r) cbn[r] = b_;
          asm volatile("" : "+v"(cbn)); }
        if (pre) { if (PROBE_PH == 22) { if (NVP == 2) asm volatile("s_waitcnt vmcnt(6) lgkmcnt(0)" ::: "memory"); else asm volatile("s_waitcnt vmcnt(4) lgkmcnt(0)" ::: "memory"); }
                   else if (NVP == 2) asm volatile("s_waitcnt vmcnt(3) lgkmcnt(0)" ::: "memory"); else asm volatile("s_waitcnt vmcnt(2) lgkmcnt(0)" ::: "memory"); }
        else asm volatile("s_waitcnt vmcnt(0) lgkmcnt(0)" ::: "memory");
        __builtin_amdgcn_s_barrier(); asm volatile("" ::: "memory");
        ksl2 = (ksl2 == 2) ? 0 : ksl2 + 1; ksl = (ksl == 2) ? 0 : ksl + 1; vsl2 = (vsl2 + 1) & 3; vsl = (vsl + 1) & 3;
    }
    if (grpB && pend) { ATT_PV(vfb + pvs * VSLOT); }
    asm volatile("s_waitcnt lgkmcnt(0)" ::: "memory"); __builtin_amdgcn_s_barrier(); asm volatile("" ::: "memory");
#undef ATT_PV
#undef ATT_VF
    if (MODE == 0) l *= exp2f(s4hi);
    { auto rr = __builtin_amdgcn_permlane32_swap(__float_as_uint(l), __float_as_uint(l), false, false); l = __uint_as_float(rr[0]) + __uint_as_float(rr[1]); }
    if (hi == 0) wsf[32 + r32] = l;
    { int hx = hi; asm volatile("" : "+v"(hx));
#pragma unroll
    for (int r = 0; r < 16; ++r) rli[r] = __builtin_amdgcn_rcpf(wsf[32 + crow(r, hx)]); }
#undef ATT_DMA
#undef ATT_WAITBAR
#undef ATT_CR
#undef ATT_CB
}

constexpr float OA8S = 8.f;
__device__ __forceinline__ u32x2 bf8_to_fp8(u32x4 w) {
    u32x2 r; int a = __builtin_amdgcn_cvt_pk_fp8_f32(__uint_as_float(w.x << 16) * OA8S, __uint_as_float(w.x & 0xffff0000u) * OA8S, 0, false);
    a = __builtin_amdgcn_cvt_pk_fp8_f32(__uint_as_float(w.y << 16) * OA8S, __uint_as_float(w.y & 0xffff0000u) * OA8S, a, true);
    int b = __builtin_amdgcn_cvt_pk_fp8_f32(__uint_as_float(w.z << 16) * OA8S, __uint_as_float(w.z & 0xffff0000u) * OA8S, 0, false);
    b = __builtin_amdgcn_cvt_pk_fp8_f32(__uint_as_float(w.w << 16) * OA8S, __uint_as_float(w.w & 0xffff0000u) * OA8S, b, true);
    r[0] = (unsigned)a; r[1] = (unsigned)b; return r; }
__device__ __forceinline__ void unit_a(LAS unsigned char* lds, const bf16_t* proj, float* oc, bf16_t* outab, const float* subw, float lam, gu32* acnt, LAS int* qbox, int b, int h, int cm, int qb, int tlo0, int tlo1, float kmax0, float kmax1) {
    const int tid = threadIdx.x, lane = tid & 63, r32 = lane & 31, hi = lane >> 5; const int wid = __builtin_amdgcn_readfirstlane(tid >> 6);
    const size_t rowb = (size_t)b * SEQ; const int q0 = qb * 256;
    const float slope2 = exp2f(-2.f * (float)(h + 1)) * LOG2E;
    const size_t grow0 = rowb + q0 + 32 * wid;
    const int c_begin = (cm == 2) ? 0 : cm, c_end = (cm == 2) ? 1 : cm;
#pragma unroll 1
    for (int c = c_begin; c <= c_end; ++c) {
        f32x16 o[4]; float rli[16];
        attn_pass<128, 0>(lds, proj, rowb, h * 128 + c * 64, 512 + h * 128 + c * 64, 1024 + h * 128, q0, c ? tlo1 : tlo0, 4 * qb + 3, slope2, nullptr, c ? kmax1 : kmax0, 0.f, o, rli, (const char*)proj + (WS_VBLK - WS_PROJ) + ((size_t)(b * 4 + h) * 128 << 14), (const char*)proj + (WS_KBLK - WS_PROJ) + ((size_t)(b * 8 + h * 2 + c) * 128 << 13));
#pragma unroll
        for (int r = 0; r < 16; ++r)
#pragma unroll
            for (int d = 0; d < 4; ++d) o[d][r] *= rli[r];
        int hx = hi; asm volatile("" : "+v"(hx));
        const unsigned ooff = (unsigned)((4 * hx) * 512 + (tid & 31)) * 4u;
        bool comb;
        if (cm == 2 && c == 1) comb = true;
        else if (cm == 2) {
            float* pv = oc + (size_t)blockIdx.x * (512 * 64) + (unsigned)tid * 4u;
#pragma unroll
            for (int r = 0; r < 16; ++r) GST(f32x4, pv + r * 2048) = (f32x4){o[0][r], o[1][r], o[2][r], o[3][r]};
            asm volatile("s_waitcnt vmcnt(0)" ::: "memory");
            comb = false;
        } else {
            char* ocb = (char*)(oc + (size_t)c * NTOK * 512 + grow0 * 512 + h * 128);
#pragma unroll
            for (int r = 0; r < 16; ++r) { float* op = (float*)(ocb + ooff + ((r & 3) + 8 * (r >> 2)) * 2048);
#pragma unroll
                for (int d = 0; d < 4; ++d) GST(float, op + d * 32) = o[d][r]; }
            asm volatile("s_waitcnt vmcnt(0)" ::: "memory");
            comb = false;
            if (cm != 2) {
                __syncthreads();
                if (tid == 0) { __builtin_amdgcn_fence(__ATOMIC_RELEASE, "agent"); asm volatile("s_waitcnt vmcnt(0)" ::: "memory");
                    const unsigned old = __hip_atomic_fetch_add(acnt + ((b * 4 + h) * 32 + qb), 1u, __ATOMIC_RELAXED, __HIP_MEMORY_SCOPE_AGENT);
                    if (old == 1u) { __builtin_amdgcn_fence(__ATOMIC_ACQUIRE, "agent"); asm volatile("s_waitcnt vmcnt(0)" ::: "memory"); }
                    qbox[4] = (int)old; }
                __syncthreads();
                comb = (__builtin_amdgcn_readfirstlane(qbox[4]) == 1);
            }
        }
        if (comb) {
            const char* ocb = (const char*)(oc + (size_t)(c ^ 1) * NTOK * 512 + grow0 * 512 + h * 128);
            float sw[4];
#pragma unroll
            for (int d = 0; d < 4; ++d) sw[d] = subw[d * 32 + r32];
            const float f0 = c ? -lam : 1.f, f1 = c ? 1.f : -lam;
            LAS bf16_t* st = (LAS bf16_t*)(lds + L_OST + wid * 8192) + (4 * hx) * 128 + r32;
            const float* pv = oc + (size_t)blockIdx.x * (512 * 64) + (unsigned)tid * 4u;
#pragma unroll
            for (int r = 0; r < 16; ++r) { const float* op = (const float*)(ocb + ooff + ((r & 3) + 8 * (r >> 2)) * 2048); float v[4]; float ss = 0.f;
                f32x4 s4;
                if (cm == 2) s4 = GLD(f32x4, pv + r * 2048); else { s4[0] = GLD(float, op); s4[1] = GLD(float, op + 32); s4[2] = GLD(float, op + 64); s4[3] = GLD(float, op + 96); }
#pragma unroll
                for (int d = 0; d < 4; ++d) { v[d] = f0 * o[d][r] + f1 * s4[d]; ss += v[d] * v[d]; }
                ss += __int_as_float(__builtin_amdgcn_update_dpp(0, __float_as_int(ss), 0xB1, 0xf, 0xf, true));
                ss += __int_as_float(__builtin_amdgcn_update_dpp(0, __float_as_int(ss), 0x4E, 0xf, 0xf, true));
                ss += __int_as_float(__builtin_amdgcn_update_dpp(0, __float_as_int(ss), 0x141, 0xf, 0xf, true));
                ss += __int_as_float(__builtin_amdgcn_update_dpp(0, __float_as_int(ss), 0x140, 0xf, 0xf, true));
                { const auto r_ = __builtin_amdgcn_permlane16_swap(__float_as_uint(ss), __float_as_uint(ss), false, false); ss = __uint_as_float(r_[0]) + __uint_as_float(r_[1]); }
                const float rinv = rsqrtf(ss * (1.f / 128.f) + LN_EPS) * (1.f - LAM_INIT);
#pragma unroll
                for (int d = 0; d < 4; ++d) st[((r & 3) + 8 * (r >> 2)) * 128 + d * 32] = (bf16_t)f2bf(v[d] * rinv * sw[d]);
                if ((r & 3) == 3) asm volatile("" ::: "memory"); }
            asm volatile("s_waitcnt lgkmcnt(0)" ::: "memory");
            int lx = lane; asm volatile("" : "+v"(lx));
            const LAS bf16_t* st2 = (const LAS bf16_t*)(lds + L_OST + wid * 8192) + (lx >> 4) * 128 + (lx & 15) * 8;
            char* oab = (char*)outab + (grow0 * D + h * 128) + (unsigned)((lx >> 4) * D + (lx & 15) * 8);
#pragma unroll
            for (int i = 0; i < 8; ++i) { const u32x4 w = *(const LAS u32x4*)(st2 + i * 4 * 128);
                GST(u32x2, oab + i * 4 * D) = bf8_to_fp8(w); }
            asm volatile("s_waitcnt vmcnt(0)" ::: "memory");
        }
    }
}
__device__ __forceinline__ void unit_b(LAS unsigned char* lds, const bf16_t* proj, bf16_t* outab, int b, int h, int qb, float kmax, float bmax) {
    const int tid = threadIdx.x, lane = tid & 63, r32 = lane & 31, hi = lane >> 5; const int wid = __builtin_amdgcn_readfirstlane(tid >> 6);
    const size_t rowb = (size_t)b * SEQ; const int q0 = qb * 256;
    f32x16 o[2]; float rli[16];
    const size_t grow0 = rowb + q0 + 32 * wid;
    const int tlo = 4 * qb - 8 < 0 ? 0 : 4 * qb - 8;
    attn_pass<64, 1>(lds, proj, rowb, 1536 + h * 64, 2048 + h * 64, 2560 + h * 64, q0, tlo, 4 * qb + 3, 0.f, (const LAS float*)(lds + L_TAB) + h * 256, kmax, bmax, o, rli, (const char*)proj + (WS_VBLK - WS_PROJ) + 32 * MiB + ((size_t)(b * 8 + h) * 128 << 13), (const char*)proj + (WS_KBLK - WS_PROJ) + 32 * MiB + ((size_t)(b * 8 + h) * 128 << 13));
    int hx = hi; asm volatile("" : "+v"(hx));
    LAS bf16_t* st = (LAS bf16_t*)(lds + L_OST + wid * 8192) + (4 * hx) * 64 + r32;
#pragma unroll
    for (int r = 0; r < 16; ++r)
#pragma unroll
        for (int d = 0; d < 2; ++d) st[((r & 3) + 8 * (r >> 2)) * 64 + d * 32] = (bf16_t)f2bf(o[d][r] * rli[r]);
    asm volatile("s_waitcnt lgkmcnt(0)" ::: "memory");
    int lx = lane; asm volatile("" : "+v"(lx));
    const LAS bf16_t* st2 = (const LAS bf16_t*)(lds + L_OST + wid * 8192) + (lx >> 3) * 64 + (lx & 7) * 8;
    char* oab = (char*)outab + (grow0 * D + 512 + h * 64) + (unsigned)((lx >> 3) * D + (lx & 7) * 8);
#pragma unroll
    for (int i = 0; i < 4; ++i) { const u32x4 w = *(const LAS u32x4*)(st2 + i * 8 * 64);
        GST(u32x2, oab + i * 8 * D) = bf8_to_fp8(w); }
    asm volatile("s_waitcnt vmcnt(0)" ::: "memory");
}
}

constexpr int RING_OFF = 0, RING_BYTES = 131072;
constexpr int MISC_OFF = 135168;
constexpr int TTAB_OFF = MISC_OFF + 256;
constexpr int TOKTAB_OFF = MISC_OFF + 8192;
constexpr int CONV_SCR6 = MISC_OFF + 256;
constexpr int LDS_BYTES = CONV_SCR6 + 16640;
constexpr int NWAVES = 8;
constexpr int CW_BAR = 4096;

#define XB_TMO      128
#define XB_XCNT(j)  (256  + 64 * (j))
#define XB_XSUB(j)  (1280 + 64 * (j))
#define XB_XGEN(j)  (2304 + 64 * (j))
#define XB_TOP      3328
#define XB_TOPGEN   3392
#define XCD_BAR_WORDS 3456
#define XB_SPIN_CAP (1u << 18)
__device__ __forceinline__ unsigned xb_ld(unsigned* p)              { return __hip_atomic_load(p, __ATOMIC_RELAXED, __HIP_MEMORY_SCOPE_AGENT); }
__device__ __forceinline__ unsigned xb_add(unsigned* p, unsigned v) { return __hip_atomic_fetch_add(p, v, __ATOMIC_RELAXED, __HIP_MEMORY_SCOPE_AGENT); }
__device__ __forceinline__ unsigned xb_xcc_id() { return (unsigned)__builtin_amdgcn_s_getreg((3 << 11) | 20) & 0xFu; }
#define XB_SPIN(cond, bar) do { unsigned _sp = 0; while (cond) { __builtin_amdgcn_s_sleep(1); \
    if ((++_sp & 255u) == 0u) { if (xb_ld(&(bar)[XB_TMO])) break; if (_sp > XB_SPIN_CAP) { atomicAdd(&(bar)[XB_TMO], 1u); break; } } } } while (0)
struct XcdBarrier { unsigned* bar; unsigned x; volatile LAS unsigned* st; };
__device__ __forceinline__ XcdBarrier xcd_barrier_post(unsigned* bar, volatile LAS unsigned* st) {
    XcdBarrier b; b.bar = bar; b.x = xb_xcc_id(); b.st = st;
    if (threadIdx.x == 0) (void)xb_add(&bar[XB_XCNT(b.x)], 1u);
    return b;
}
__device__ __forceinline__ void xcd_barrier_complete(unsigned* bar, unsigned x, unsigned& nloc, unsigned& nx) {
    const unsigned G = gridDim.x * gridDim.y * gridDim.z;
    unsigned sum, cnt, mine, sp = 0u;
    for (;;) {
        sum = 0u; cnt = 0u; mine = 0u;
#pragma unroll
        for (unsigned j = 0; j < 16; ++j) { const unsigned c = xb_ld(&bar[XB_XCNT(j)]); sum += c; cnt += (c > 0u) ? 1u : 0u; mine = (j == x) ? c : mine; }
        if (sum == G) break;
        __builtin_amdgcn_s_sleep(1);
        if ((++sp & 255u) == 0u) { if (xb_ld(&bar[XB_TMO])) break; if (sp > XB_SPIN_CAP) { atomicAdd(&bar[XB_TMO], 1u); break; } }
    }
    nloc = mine > 0u ? mine : 1u; nx = cnt > 0u ? cnt : 1u;
}
__device__ __forceinline__ void xcd_barrier(const XcdBarrier& b) {
    asm volatile("s_waitcnt vmcnt(0)" ::: "memory");
    __syncthreads();
    if (threadIdx.x == 0) {
        unsigned* bar = b.bar;
        __builtin_amdgcn_s_waitcnt(0);
        unsigned nloc = b.st[0], nx = b.st[1];
        if (nloc == 0u) { xcd_barrier_complete(bar, b.x, nloc, nx); b.st[0] = nloc; b.st[1] = nx; }
        const unsigned old = xb_add(&bar[XB_XSUB(b.x)], 1u);
        const unsigned gen = old / nloc;
        if (old + 1u == (gen + 1u) * nloc) {
            __builtin_amdgcn_fence(__ATOMIC_RELEASE, "agent");
            asm volatile("s_waitcnt vmcnt(0)" ::: "memory");
            const unsigned og = xb_add(&bar[XB_TOP], 1u);
            const unsigned tg = og / nx;
            if (og + 1u == (tg + 1u) * nx) xb_add(&bar[XB_TOPGEN], 1u);
            else XB_SPIN(xb_ld(&bar[XB_TOPGEN]) == tg, bar);
            __builtin_amdgcn_fence(__ATOMIC_ACQUIRE, "agent");
            xb_add(&bar[XB_XGEN(b.x)], 1u);
            asm volatile("s_waitcnt vmcnt(0)" ::: "memory");
        } else {
            XB_SPIN(xb_ld(&bar[XB_XGEN(b.x)]) == gen, bar);
            __builtin_amdgcn_fence(__ATOMIC_ACQUIRE, "agent");
            asm volatile("s_waitcnt vmcnt(0)" ::: "memory");
        }
    }
    __syncthreads();
}

struct Args {
    const float* in[24]; float* out; unsigned char* ws; int ph_lo, ph_hi, li, pad_;
};
static_assert(sizeof(Args) == 24 * 8 + 8 + 8 + 16, "Args has no padding");

__device__ __forceinline__ void p0_transpose_item(const float* W, int K, int N, bf16_t* WT, int k0, int n0, int rowbase, LAS float* scr, int lane) {
    const float* wp = W + (size_t)(k0 + (lane >> 4)) * N + n0 + (lane & 15) * 4;
    f32x4 v[16];
#pragma unroll
    for (int i = 0; i < 16; ++i) v[i] = *(const f32x4*)(wp + (size_t)(4 * i) * N);
#pragma unroll
    for (int i = 0; i < 16; ++i) { LAS float* d = scr + (4 * i + (lane >> 4)) * 65 + (lane & 15) * 4; d[0] = v[i][0]; d[1] = v[i][1]; d[2] = v[i][2]; d[3] = v[i][3]; }
    asm volatile("s_waitcnt lgkmcnt(0)" ::: "memory");
    const int c = lane & 7;
#pragma unroll
    for (int j = 0; j < 8; ++j) { const int n = (lane >> 3) + 8 * j; const LAS float* sp = scr + (8 * c) * 65 + n;
        u32x4 o; o.x = pg::cvt_pk_bf16(sp[0 * 65], sp[1 * 65]); o.y = pg::cvt_pk_bf16(sp[2 * 65], sp[3 * 65]); o.z = pg::cvt_pk_bf16(sp[4 * 65], sp[5 * 65]); o.w = pg::cvt_pk_bf16(sp[6 * 65], sp[7 * 65]);
        GST(u32x4, WT + (size_t)(rowbase + n) * K + k0 + 8 * c) = o; }
    asm volatile("s_waitcnt lgkmcnt(0)" ::: "memory");
}
constexpr float S8S = 64.f, S8SI = 1.f / 64.f;
constexpr float A8S = 4.f, A8SI = 0.25f;
constexpr float M8S = 16.f, M8SI = 1.f / 16.f;
constexpr float W8S = 64.f, W8SI = 1.f / 64.f;
__device__ __forceinline__ unsigned pack4_u8(float a, float b, float c, float d) {
    return (unsigned)(a + 0.5f) | ((unsigned)(b + 0.5f) << 8) | ((unsigned)(c + 0.5f) << 16) | ((unsigned)(d + 0.5f) << 24); }
__device__ __forceinline__ u32x4 widen16(u32x2 a, u32x2 b) {
    const auto r0 = __builtin_amdgcn_permlane16_swap(a[0], b[0], false, false); const auto r1 = __builtin_amdgcn_permlane16_swap(a[1], b[1], false, false);
    return (u32x4){r0[0], r1[0], r0[1], r1[1]}; }
__device__ __forceinline__ unsigned pack4_fp8(float a, float b, float c, float d) { int w = __builtin_amdgcn_cvt_pk_fp8_f32(a, b, 0, false); w = __builtin_amdgcn_cvt_pk_fp8_f32(c, d, w, true); return (unsigned)w; }
__device__ __forceinline__ void p0_transpose_item_f8(const float* W, int K, int N, unsigned char* WT, int k0, int n0, int rowbase, LAS float* scr, int lane) {
    const float* wp = W + (size_t)(k0 + (lane >> 4)) * N + n0 + (lane & 15) * 4;
    f32x4 v[16];
#pragma unroll
    for (int i = 0; i < 16; ++i) v[i] = *(const f32x4*)(wp + (size_t)(4 * i) * N);
#pragma unroll
    for (int i = 0; i < 16; ++i) { LAS float* d = scr + (4 * i + (lane >> 4)) * 65 + (lane & 15) * 4; d[0] = v[i][0]; d[1] = v[i][1]; d[2] = v[i][2]; d[3] = v[i][3]; }
    asm volatile("s_waitcnt lgkmcnt(0)" ::: "memory");
    const int c = lane & 3;
#pragma unroll
    for (int j = 0; j < 4; ++j) { const int n = (lane >> 2) + 16 * j; const LAS float* sp = scr + (16 * c) * 65 + n;
        u32x4 o;
        o.x = pack4_fp8(sp[0 * 65] * W8S, sp[1 * 65] * W8S, sp[2 * 65] * W8S, sp[3 * 65] * W8S); o.y = pack4_fp8(sp[4 * 65] * W8S, sp[5 * 65] * W8S, sp[6 * 65] * W8S, sp[7 * 65] * W8S);
        o.z = pack4_fp8(sp[8 * 65] * W8S, sp[9 * 65] * W8S, sp[10 * 65] * W8S, sp[11 * 65] * W8S); o.w = pack4_fp8(sp[12 * 65] * W8S, sp[13 * 65] * W8S, sp[14 * 65] * W8S, sp[15 * 65] * W8S);
        GST(u32x4, WT + (size_t)(rowbase + n) * K + k0 + 16 * c) = o; }
    asm volatile("s_waitcnt lgkmcnt(0)" ::: "memory");
}
struct P0Item { const float* W; unsigned char* WT; int N, K, k0, n0, rowbase, f8; };
__device__ __forceinline__ void p0_load(const P0Item& I, f32x4 (&v)[16], int lane) {
    const float* wp = I.W + (size_t)(I.k0 + (lane >> 4)) * I.N + I.n0 + (lane & 15) * 4;
#pragma unroll
    for (int i = 0; i < 16; ++i) v[i] = GLD_NT(f32x4, wp + (size_t)(4 * i) * I.N);
}
typedef int v2i32_tr __attribute__((ext_vector_type(2)));
__device__ __forceinline__ void p0_proc(const P0Item& I, const f32x4 (&v)[16], LAS float* scr, int lane) {
    if (I.f8) {
        LAS unsigned char* t8 = (LAS unsigned char*)scr;
#pragma unroll
        for (int i = 0; i < 16; ++i) *(LAS unsigned*)(t8 + (4 * i + (lane >> 4)) * 72 + (lane & 15) * 4) = pack4_fp8(v[i][0] * W8S, v[i][1] * W8S, v[i][2] * W8S, v[i][3] * W8S);
        asm volatile("s_waitcnt lgkmcnt(0)" ::: "memory");
        const int g = lane >> 4, l16 = lane & 15; const LAS unsigned char* rb = t8 + (16 * g + (l16 >> 1)) * 72 + (l16 & 1) * 8;
#pragma unroll
        for (int nb = 0; nb < 4; ++nb) { const v2i32_tr r0 = __builtin_amdgcn_ds_read_tr8_b64_v2i32((LAS v2i32_tr*)(rb + nb * 16)), r1 = __builtin_amdgcn_ds_read_tr8_b64_v2i32((LAS v2i32_tr*)(rb + 8 * 72 + nb * 16));
            GST(u32x4, I.WT + (size_t)(I.rowbase + nb * 16 + l16) * I.K + I.k0 + 16 * g) = (u32x4){(unsigned)r0[0], (unsigned)r0[1], (unsigned)r1[0], (unsigned)r1[1]}; }
        asm volatile("s_waitcnt lgkmcnt(0)" ::: "memory");
        return;
    }
#pragma unroll
    for (int i = 0; i < 16; ++i) { LAS float* d = scr + (4 * i + (lane >> 4)) * 65 + (lane & 15) * 4; d[0] = v[i][0]; d[1] = v[i][1]; d[2] = v[i][2]; d[3] = v[i][3]; }
    asm volatile("s_waitcnt lgkmcnt(0)" ::: "memory");
    if (I.f8) { const int c = lane & 3;
#pragma unroll
        for (int j = 0; j < 4; ++j) { const int n = (lane >> 2) + 16 * j; const LAS float* sp = scr + (16 * c) * 65 + n;
            u32x4 o;
            o.x = pack4_fp8(sp[0 * 65] * W8S, sp[1 * 65] * W8S, sp[2 * 65] * W8S, sp[3 * 65] * W8S); o.y = pack4_fp8(sp[4 * 65] * W8S, sp[5 * 65] * W8S, sp[6 * 65] * W8S, sp[7 * 65] * W8S);
            o.z = pack4_fp8(sp[8 * 65] * W8S, sp[9 * 65] * W8S, sp[10 * 65] * W8S, sp[11 * 65] * W8S); o.w = pack4_fp8(sp[12 * 65] * W8S, sp[13 * 65] * W8S, sp[14 * 65] * W8S, sp[15 * 65] * W8S);
            GST(u32x4, I.WT + (size_t)(I.rowbase + n) * I.K + I.k0 + 16 * c) = o; }
    } else { const int c = lane & 7;
#pragma unroll
        for (int j = 0; j < 8; ++j) { const int n = (lane >> 3) + 8 * j; const LAS float* sp = scr + (8 * c) * 65 + n;
            u32x4 o; o.x = pg::cvt_pk_bf16(sp[0 * 65], sp[1 * 65]); o.y = pg::cvt_pk_bf16(sp[2 * 65], sp[3 * 65]); o.z = pg::cvt_pk_bf16(sp[4 * 65], sp[5 * 65]); o.w = pg::cvt_pk_bf16(sp[6 * 65], sp[7 * 65]);
            GST(u32x4, I.WT + ((size_t)(I.rowbase + n) * I.K + I.k0 + 8 * c) * 2) = o; }
    }
    asm volatile("s_waitcnt lgkmcnt(0)" ::: "memory");
}
template <int R>
__device__ __forceinline__ void ln_rows_in(const float* x, const float* g, const float* b, bf16_t* xn, unsigned char* xn8, int row0, int rstride, int lane) {
    float4 v[R][4];
#pragma unroll
    for (int q = 0; q < R; ++q) { const float4* xr = (const float4*)(x + (size_t)(row0 + q * rstride) * D) + lane;
#pragma unroll
        for (int j = 0; j < 4; ++j) { const f32x4 t_ = GLD_NT(f32x4, xr + 64 * j); v[q][j] = make_float4(t_[0], t_[1], t_[2], t_[3]); } }
#pragma unroll
    for (int q = 0; q < R; ++q) { const int row = row0 + q * rstride; float s = 0.f;
#pragma unroll
        for (int j = 0; j < 4; ++j) s += (v[q][j].x + v[q][j].y) + (v[q][j].z + v[q][j].w);
        const float mean = wave_sum(s) * (1.f / D); float s2 = 0.f;
#pragma unroll
        for (int j = 0; j < 4; ++j) { v[q][j].x -= mean; v[q][j].y -= mean; v[q][j].z -= mean; v[q][j].w -= mean; s2 += (v[q][j].x * v[q][j].x + v[q][j].y * v[q][j].y) + (v[q][j].z * v[q][j].z + v[q][j].w * v[q][j].w); }
        const float rstd = rsqrtf(wave_sum(s2) * (1.f / D) + LN_EPS);
#pragma unroll
        for (int j = 0; j < 4; ++j) {
            const int c = (lane + 64 * j) * 4; const float4 gg = *(const float4*)(g + c), bb = *(const float4*)(b + c);
            const float h0 = v[q][j].x * rstd * gg.x + bb.x, h1 = v[q][j].y * rstd * gg.y + bb.y, h2 = v[q][j].z * rstd * gg.z + bb.z, h3 = v[q][j].w * rstd * gg.w + bb.w;
            uint2 o; o.x = f2bf(h0) | (f2bf(h1) << 16); o.y = f2bf(h2) | (f2bf(h3) << 16);
            GST(u32x2, xn + (size_t)row * D + c) = (u32x2){o.x, o.y};
            { const unsigned w0 = pack4_fp8(h0, h1, h2, h3); const unsigned w1 = (unsigned)__builtin_amdgcn_update_dpp(0, (int)w0, 0x55, 0xf, 0xf, true), w2 = (unsigned)__builtin_amdgcn_update_dpp(0, (int)w0, 0xAA, 0xf, 0xf, true), w3 = (unsigned)__builtin_amdgcn_update_dpp(0, (int)w0, 0xFF, 0xf, 0xf, true);
              if ((lane & 3) == 0) GST(u32x4, xn8 + (size_t)row * D + c) = (u32x4){w0, w1, w2, w3}; }
        } }
}

struct EpiProj {
    static constexpr bool BIASLDS = false; static constexpr bool ROWINFO = false; static constexpr bool PERM = true;
    bf16_t* O; int* nrmsq; unsigned char* vblk; unsigned char* kblk;
    __device__ __forceinline__ bool operator()(f32x4 (&acc)[2][2][4][2], const pg::Unit& u, int wr, int wc, int fr, int fq) const {
        const int row0 = u.pm * 256 + wr * 64 + fr, col0 = u.pn * 256 + wc * 32 + 8 * fq;
        const int kind = (u.pn < 2 || (u.pn >= 6 && u.pn < 8)) ? 1 : 0; const int vkind = (u.pn == 4 || u.pn == 5) ? 1 : ((u.pn == 10 || u.pn == 11) ? 2 : ((u.pn == 2 || u.pn == 3) ? 3 : ((u.pn == 8 || u.pn == 9) ? 4 : 0)));
        if (u.pn < 4 || u.pn == 8 || u.pn == 9) {
            const int nk = u.pn < 2 ? 1 : (u.pn < 4 ? 0 : 2); const float sc = u.pn < 2 ? C2 : 1.f; const int bb_ = u.pm >> 5;
#pragma unroll
            for (int ai = 0; ai < 2; ++ai)
#pragma unroll
                for (int bj = 0; bj < 2; ++bj) { float mx = 0.f;
#pragma unroll
                    for (int m = 0; m < 4; ++m) { const f32x4 a0 = acc[ai][bj][m][0] * sc, a1 = acc[ai][bj][m][1] * sc;
                        float ss = (a0[0] * a0[0] + a0[1] * a0[1]) + (a0[2] * a0[2] + a0[3] * a0[3]) + (a1[0] * a1[0] + a1[1] * a1[1]) + (a1[2] * a1[2] + a1[3] * a1[3]);
                        { auto r_ = __builtin_amdgcn_permlane16_swap(__float_as_uint(ss), __float_as_uint(ss), false, false); ss = __uint_as_float(r_[0]) + __uint_as_float(r_[1]); }
                        { auto r_ = __builtin_amdgcn_permlane32_swap(__float_as_uint(ss), __float_as_uint(ss), false, false); ss = __uint_as_float(r_[0]) + __uint_as_float(r_[1]); }
                        mx = fmaxf(mx, ss); }
                    mx = fmaxf(mx, __int_as_float(__builtin_amdgcn_update_dpp(0, __float_as_int(mx), 0xB1, 0xf, 0xf, true)));
                    mx = fmaxf(mx, __int_as_float(__builtin_amdgcn_update_dpp(0, __float_as_int(mx), 0x4E, 0xf, 0xf, true)));
                    mx = fmaxf(mx, __int_as_float(__builtin_amdgcn_update_dpp(0, __float_as_int(mx), 0x141, 0xf, 0xf, true)));
                    mx = fmaxf(mx, __int_as_float(__builtin_amdgcn_update_dpp(0, __float_as_int(mx), 0x140, 0xf, 0xf, true)));
                    const int head = nk == 2 ? (bb_ * 8 + 4 * (u.pn - 8) + 2 * bj + (wc >> 1)) : ((bb_ * 4 + 2 * (u.pn & 1) + bj) * 2 + (wc >> 1));
                    const int tl = 4 * (u.pm & 31) + 2 * ai + wr;
                    if (fr == 0 && fq == 0) __hip_atomic_fetch_max(nrmsq + (nk * 32 + head) * 128 + tl, (int)__float_as_uint(mx), __ATOMIC_RELAXED, __HIP_MEMORY_SCOPE_AGENT); }
        }
#pragma unroll
        for (int ai = 0; ai < 2; ++ai)
#pragma unroll
            for (int m = 0; m < 4; ++m) { bf16_t* rowp = O + (size_t)(row0 + ai * 128 + m * 16) * INC + col0;
                const int tl_ = (u.pm & 31) * 4 + wr + 2 * ai, bb_ = u.pm >> 5; const unsigned ln16 = (unsigned)(fr * 4 + fq) * 16u;
#pragma unroll
                for (int bj = 0; bj < 2; ++bj) { f32x4 v0 = acc[ai][bj][m][0], v1 = acc[ai][bj][m][1];
                    if (kind == 1) { v0 = v0 * C2; v1 = v1 * C2; }
                    if (vkind == 1) { const float wk = exp2f(exp2f(-2.f * (float)((u.pn - 4) * 2 + bj + 1)) * LOG2E * (float)(m * 16 + fr)); v0 = v0 * wk; v1 = v1 * wk; }
                    u32x4 w; w.x = pg::cvt_pk_bf16(v0[0], v0[1]); w.y = pg::cvt_pk_bf16(v0[2], v0[3]); w.z = pg::cvt_pk_bf16(v1[0], v1[1]); w.w = pg::cvt_pk_bf16(v1[2], v1[3]);
                    if (vkind == 1) GST(u32x4, vblk + ((size_t)((bb_ * 4 + (u.pn - 4) * 2 + bj) * 128 + tl_) << 14) + (unsigned)((wc * 4 + m) * 1024) + ln16) = w;
                    else if (vkind == 2) GST(u32x4, vblk + 32 * MiB + ((size_t)((bb_ * 8 + (u.pn - 10) * 4 + bj * 2 + (wc >> 1)) * 128 + tl_) << 13) + (unsigned)(((wc & 1) * 4 + m) * 1024) + ln16) = w;
                    else if (vkind >= 3) {
                        const int hc_ = (vkind == 3 ? (u.pn - 2) : (u.pn - 8)) * 4 + bj * 2 + (wc >> 1);
                        GST(u32x4, kblk + (vkind == 4 ? 32 * MiB : 0) + ((size_t)((bb_ * 8 + hc_) * 128 + tl_) << 13) + (unsigned)((((wc & 1) * 4 + fq) * 64 + m * 16 + fr) * 16)) = w; }
                    else GST(u32x4, rowp + bj * 128) = w; } }
        return false;
    }
};
struct EpiGates {
    static constexpr bool BIASLDS = false; static constexpr bool ROWINFO = false; static constexpr bool PERM = true; static constexpr int NST = 8;
    unsigned char* G; const float* bgate; float gscale;
    __device__ __forceinline__ bool operator()(f32x4 (&acc)[2][2][4][2], const pg::Unit& u, int wr, int wc, int fr, int fq) const {
        const int col0 = u.pn * 256 + wc * 32 + 8 * fq - 3072;
        const unsigned tid_ = (unsigned)((wr * 4 + wc) * 64 + fq * 16 + fr);
        unsigned char* gb = G + ((size_t)(u.pm * 8 + (u.pn - 12)) * 8) * 8192 + tid_ * 16u;
        f32x2 bv[2][4];
#pragma unroll
        for (int bj = 0; bj < 2; ++bj)
#pragma unroll
            for (int h = 0; h < 4; ++h) bv[bj][h] = *(const f32x2*)(bgate + col0 + bj * 128 + 2 * h) * (-LOG2E);
        const f32x2 kn = {-LOG2E * gscale, -LOG2E * gscale}, one = {1.f, 1.f}, k255 = {255.f, 255.f}, magic = {8388608.f, 8388608.f};
#pragma unroll
        for (int ai = 0; ai < 2; ++ai)
#pragma unroll
            for (int m = 0; m < 4; ++m) { u32x2 gwv[2];
#pragma unroll
                for (int bj = 0; bj < 2; ++bj) { unsigned zb[8];
#pragma unroll
                    for (int h = 0; h < 4; ++h) { const f32x4 av = acc[ai][bj][m][h >> 1];
                        f32x2 e = (f32x2){av[2 * (h & 1)], av[2 * (h & 1) + 1]} * kn + bv[bj][h];
                        e[0] = __builtin_amdgcn_exp2f(e[0]); e[1] = __builtin_amdgcn_exp2f(e[1]); e = e + one;
                        e[0] = __builtin_amdgcn_rcpf(e[0]); e[1] = __builtin_amdgcn_rcpf(e[1]); e = e * k255 + magic;
                        zb[2 * h] = __float_as_uint(e[0]); zb[2 * h + 1] = __float_as_uint(e[1]); }
                    gwv[bj].x = __builtin_amdgcn_perm(zb[1], zb[0], 0x0c0c0400u) | (__builtin_amdgcn_perm(zb[3], zb[2], 0x0c0c0400u) << 16);
                    gwv[bj].y = __builtin_amdgcn_perm(zb[5], zb[4], 0x0c0c0400u) | (__builtin_amdgcn_perm(zb[7], zb[6], 0x0c0c0400u) << 16); }
                GST_NT(u32x4, gb + (ai * 4 + m) * 8192, ((u32x4){gwv[0].x, gwv[0].y, gwv[1].x, gwv[1].y})); }
        return false;
    }
};
struct SchedDense {
    pg::GridOrder go; const char* A; const char* B; size_t tstepA, tstepB; int pn_off;
    __device__ __forceinline__ bool next(int i, pg::Unit& u) const { int pm, pn; if (!go.tile(i, pm, pn)) return false; u.pm = pm; u.pn = pn + pn_off; u.x0 = 0; u.x1 = 0; u.x2 = 0; u.x3 = 0; u.A = A + (size_t)pm * tstepA; u.B = B + (size_t)pn * tstepB; return true; }
};

__device__ __forceinline__ float bflo(unsigned w) { return __uint_as_float(w << 16); }
__device__ __forceinline__ float bfhi(unsigned w) { return __uint_as_float(w & 0xffff0000u); }
struct EpiMerged {
    static constexpr bool BIASLDS = false; static constexpr bool ROWINFO = false; static constexpr bool PERM = true; static constexpr int NST = 0;
    const unsigned char* G; bf16_t* merged;
    __device__ __forceinline__ bool operator()(f32x4 (&acc)[2][2][4][2], const pg::Unit& u, int wr, int wc, int fr, int fq) const {
        const int row0 = u.pm * 256 + wr * 64 + fr, col0 = u.pn * 256 + wc * 32 + 8 * fq; const bool first = (u.x0 == 0);
        const unsigned tid_ = (unsigned)((wr * 4 + wc) * 64 + fq * 16 + fr);
        const unsigned char* g0b = G + ((size_t)(u.pm * 8 + u.pn) * 8) * 8192 + tid_ * 16u; const unsigned char* g1b = g0b + (size_t)4 * 8 * 8192;
#pragma unroll
        for (int ai = 0; ai < 2; ++ai)
#pragma unroll
            for (int m = 0; m < 4; ++m) { const size_t row = (size_t)(row0 + ai * 128 + m * 16);
                const u32x4 g1q = GLD(u32x4, g1b + (ai * 4 + m) * 8192); u32x4 g0q = {0u, 0u, 0u, 0u}; if (first) g0q = GLD(u32x4, g0b + (ai * 4 + m) * 8192);
#pragma unroll
                for (int bj = 0; bj < 2; ++bj) {
                    const unsigned g1x = bj ? g1q.z : g1q.x, g1y = bj ? g1q.w : g1q.y;
                    float g1[8];
#pragma unroll
                    for (int q = 0; q < 4; ++q) { g1[q] = fmaxf((float)((g1x >> (8 * q)) & 255u), 1e-30f); g1[4 + q] = fmaxf((float)((g1y >> (8 * q)) & 255u), 1e-30f); }
                    if (first) {
                        const unsigned g0x = bj ? g0q.z : g0q.x, g0y = bj ? g0q.w : g0q.y;
#pragma unroll
                        for (int q = 0; q < 4; ++q) { acc[ai][bj][m][0][q] *= (float)((g0x >> (8 * q)) & 255u) * __builtin_amdgcn_rcpf(g1[q]); acc[ai][bj][m][1][q] *= (float)((g0y >> (8 * q)) & 255u) * __builtin_amdgcn_rcpf(g1[4 + q]); }
                    } else {
                        f32x4 v0 = acc[ai][bj][m][0], v1 = acc[ai][bj][m][1];
#pragma unroll
                        for (int q = 0; q < 4; ++q) { v0[q] *= g1[q] * (M8S / 255.f * W8SI / att::OA8S); v1[q] *= g1[4 + q] * (M8S / 255.f * W8SI / att::OA8S); }
                        u32x2 w; w.x = pack4_fp8(v0[0], v0[1], v0[2], v0[3]); w.y = pack4_fp8(v1[0], v1[1], v1[2], v1[3]);
                        GST(u32x2, (unsigned char*)merged + row * D + col0 + bj * 128) = w;
                    } } }
        return first;
    }
};
struct SchedMerged {
    pg::GridOrder go; const char* outab; const char* wa; const char* wb;
    __device__ __forceinline__ bool next(int i, pg::Unit& u) const { int pm, pn; if (!go.tile(i >> 1, pm, pn)) return false; const int br = i & 1; u.pm = pm; u.pn = pn; u.x0 = br; u.x1 = 0; u.x2 = 0; u.x3 = 0;
        u.A = outab + (size_t)pm * 256 * 1024 + br * 512; u.B = (br ? wb : wa) + (size_t)pn * 256 * 512; return true; }
};
struct EpiY {
    static constexpr bool BIASLDS = false; static constexpr bool ROWINFO = false; static constexpr bool PERM = true;
    bf16_t* o;
    __device__ __forceinline__ bool operator()(f32x4 (&acc)[2][2][4][2], const pg::Unit& u, int wr, int wc, int fr, int fq) const {
        const int row0 = u.pm * 256 + wr * 64 + fr, col0 = u.pn * 256 + wc * 32 + 8 * fq;
#pragma unroll
        for (int ai = 0; ai < 2; ++ai)
#pragma unroll
            for (int m = 0; m < 4; ++m) { bf16_t* rowp = o + (size_t)(row0 + ai * 128 + m * 16) * D + col0;
#pragma unroll
                for (int bj = 0; bj < 2; ++bj) { const f32x4 v0 = acc[ai][bj][m][0] * (W8SI * M8SI), v1 = acc[ai][bj][m][1] * (W8SI * M8SI);
                    u32x4 w; w.x = pg::cvt_pk_bf16(v0[0], v0[1]); w.y = pg::cvt_pk_bf16(v0[2], v0[3]); w.z = pg::cvt_pk_bf16(v1[0], v1[1]); w.w = pg::cvt_pk_bf16(v1[2], v1[3]);
                    GST(u32x4, rowp + bj * 128) = w; } }
        return false;
    }
};
__device__ __forceinline__ void build_tile_table(LAS int* tt, const gu32* cnt, int tid) {
    LAS int* texp = tt; LAS int* tpos = tt + MAXT; LAS int* lcnt = tt + 2 * MAXT; LAS int* ntl = tt + 2 * MAXT + 32;
    if (tid < 32) lcnt[tid] = (int)__hip_atomic_load(cnt + tid, __ATOMIC_RELAXED, __HIP_MEMORY_SCOPE_AGENT);
    __syncthreads();
    if (tid < 32) { int base = 0; for (int e = 0; e < tid; ++e) base += (lcnt[e] + 255) >> 8; const int n = (lcnt[tid] + 255) >> 8;
        for (int j = 0; j < n; ++j) { texp[base + j] = tid; tpos[base + j] = j * 256; } if (tid == 31) ntl[0] = base + n; }
    __syncthreads();
}
struct SchedExpert {
    pg::GridOrder go; LAS int* tt; const char* A; const char* B; size_t bstride_e, bstride_n, astride_t; bool gatherA;
    __device__ __forceinline__ bool next(int i, pg::Unit& u) const { int t, pn; if (!go.tile(i, t, pn)) return false;
        const int e = __builtin_amdgcn_readfirstlane(tt[t]), tp = __builtin_amdgcn_readfirstlane(tt[MAXT + t]), n = __builtin_amdgcn_readfirstlane(tt[2 * MAXT + e]);
        u.pm = t; u.pn = pn; u.x0 = e; u.x1 = tp; u.x2 = n; u.x3 = e * LCAP + tp;
        u.A = gatherA ? A : A + (size_t)t * astride_t; u.B = B + (size_t)e * bstride_e + (size_t)pn * bstride_n; return true; }
};
struct EpiSwiglu {
    static constexpr bool BIASLDS = true; static constexpr bool ROWINFO = false; static constexpr bool PERM = true;
    const float* bias; bf16_t* abuf;
    __device__ __forceinline__ const float* bias_src(const pg::Unit& u, int lane) const { return bias + (size_t)u.x0 * 2 * DFF + (lane >= 32 ? DFF : 0) + u.pn * 128 + (lane & 31) * 4; }
    __device__ __forceinline__ bool operator()(f32x4 (&acc)[2][2][4][2], const pg::Unit& u, int wr, int wc, int fr, int fq, const LAS float* bl) const {
        const int row0 = u.pm * 256 + wr * 64 + fr, j0 = u.pn * 128 + wc * 32 + 8 * fq; const LAS float* bp = bl + wc * 32 + 8 * fq;
        f32x2 bg[4], bu[4];
#pragma unroll
        for (int h = 0; h < 4; ++h) { bg[h] = *(const LAS f32x2*)(bp + 2 * h); const f32x2 t = *(const LAS f32x2*)(bp + 128 + 2 * h); bu[h] = (t + 1.f) * A8S; }
        const f32x2 kg = {W8SI, W8SI}, ku = {W8SI * A8S, W8SI * A8S}, ke = {-SWA * LOG2E, -SWA * LOG2E}, one = {1.f, 1.f};
        u32x2 wm[2];
#pragma unroll
        for (int ai = 0; ai < 2; ++ai)
#pragma unroll
            for (int m = 0; m < 4; ++m) {
                f32x2 a[4];
#pragma unroll
                for (int h = 0; h < 4; ++h) { const f32x4 ag = acc[ai][0][m][h >> 1], au = acc[ai][1][m][h >> 1];
                    f32x2 g = (f32x2){ag[2 * (h & 1)], ag[2 * (h & 1) + 1]} * kg + bg[h], uu = (f32x2){au[2 * (h & 1)], au[2 * (h & 1) + 1]} * ku + bu[h];
                    g[0] = fminf(g[0], SWL); g[1] = fminf(g[1], SWL);
                    uu[0] = __builtin_amdgcn_fmed3f(uu[0], (1.f - SWL) * A8S, (1.f + SWL) * A8S); uu[1] = __builtin_amdgcn_fmed3f(uu[1], (1.f - SWL) * A8S, (1.f + SWL) * A8S);
                    f32x2 e = g * ke; e[0] = __builtin_amdgcn_exp2f(e[0]); e[1] = __builtin_amdgcn_exp2f(e[1]);
                    e = e + one; e[0] = __builtin_amdgcn_rcpf(e[0]); e[1] = __builtin_amdgcn_rcpf(e[1]);
                    a[h] = (g * e) * uu; }
                wm[m & 1].x = pack4_fp8(a[0][0], a[0][1], a[1][0], a[1][1]); wm[m & 1].y = pack4_fp8(a[2][0], a[2][1], a[3][0], a[3][1]);
                if (m & 1) { const size_t row = (size_t)(row0 + ai * 128 + (m - 1 + (fq & 1)) * 16);
                    GST(u32x4, (unsigned char*)abuf + row * DFF + j0 - 8 * (fq & 1)) = widen16(wm[0], wm[1]); } }
        return false;
    }
};
struct EpiScatter {
    static constexpr bool BIASLDS = true; static constexpr bool ROWINFO = true; static constexpr bool PERM = true;
    const float* bias; const float* listw; bf16_t* slot;
    __device__ __forceinline__ const float* bias_src(const pg::Unit& u, int lane) const { return bias + (size_t)u.x0 * D + u.pn * 256 + lane * 4; }
    __device__ __forceinline__ bool operator()(f32x4 (&acc)[2][2][4][2], const pg::Unit& u, int wr, int wc, int fr, int fq, const LAS unsigned* tab, const LAS float* bl) const {
        const int r0 = wr * 64 + fr, col0 = u.pn * 256 + wc * 32 + 8 * fq; const LAS float* bp = bl + wc * 32 + 8 * fq;
        const int colw = (fq & 1) ? col0 - 8 + 128 : col0;
        f32x4 bv[2][2];
#pragma unroll
        for (int bj = 0; bj < 2; ++bj)
#pragma unroll
            for (int n = 0; n < 2; ++n) bv[bj][n] = *(const LAS f32x4*)(bp + bj * 128 + 4 * n);
#pragma unroll
        for (int ai = 0; ai < 2; ++ai)
#pragma unroll
            for (int m = 0; m < 4; ++m) { const int r = r0 + ai * 128 + m * 16; const bool valid = (u.x1 + r) < u.x2;
                const int slv_ = (int)tab[r]; const int sl = slv_ + ((NTOK * 4 - slv_) & -(int)(!valid)); const float wg2 = __uint_as_float(tab[512 + r]) * S8S;
                u32x2 w[2];
#pragma unroll
                for (int bj = 0; bj < 2; ++bj) { const f32x4 v0 = (acc[ai][bj][m][0] * (W8SI * A8SI) + bv[bj][0]) * wg2, v1 = (acc[ai][bj][m][1] * (W8SI * A8SI) + bv[bj][1]) * wg2;
                    w[bj].x = pack4_fp8(v0[0], v0[1], v0[2], v0[3]); w[bj].y = pack4_fp8(v1[0], v1[1], v1[2], v1[3]); }
                GST_NT(u32x4, (unsigned char*)slot + (size_t)sl * D + colw, widen16(w[0], w[1])); }
        return false;
    }
};
__device__ __forceinline__ void split8(const f32x4 x0, const f32x4 x1, bf16x8& hi, bf16x8& lo) {
    u32x4 h; h.x = pg::cvt_pk_bf16(x0[0], x0[1]); h.y = pg::cvt_pk_bf16(x0[2], x0[3]); h.z = pg::cvt_pk_bf16(x1[0], x1[1]); h.w = pg::cvt_pk_bf16(x1[2], x1[3]);
    u32x4 l; l.x = pg::cvt_pk_bf16(x0[0] - bflo(h.x), x0[1] - bfhi(h.x)); l.y = pg::cvt_pk_bf16(x0[2] - bflo(h.y), x0[3] - bfhi(h.y));
    l.z = pg::cvt_pk_bf16(x1[0] - bflo(h.z), x1[1] - bfhi(h.z)); l.w = pg::cvt_pk_bf16(x1[2] - bflo(h.w), x1[3] - bfhi(h.w));
    hi = __builtin_bit_cast(bf16x8, h); lo = __builtin_bit_cast(bf16x8, l); }
__device__ __forceinline__ void p5_router(LAS unsigned char* lds, const bf16_t* xnb, const float* g0, const float* b0, const bf16_t* att, float2* st1, const float* g, const float* b, const float* wr, const float* br, bf16_t* h1b, unsigned char* h1f8, int* topi, float* topw, gu32* cnt, int* list, float* listw, int rowbase, int tid, int lane, int wave) {
    LAS float* hs = (LAS float*)lds;
    LAS float* part = (LAS float*)(lds + 65536);
    LAS unsigned* hist = (LAS unsigned*)(lds + 65536 + 16384);
    LAS unsigned* basep = hist + 32;
    LAS unsigned short* sle = (LAS unsigned short*)(lds + 65536 + 16384 + 256);
    LAS unsigned short* slp = sle + 512;
    LAS float* slw = (LAS float*)(slp + 512);
    const int e = lane & 31, half = lane >> 5, d0 = wave * 128 + half * 64;
    if (tid < 32) hist[tid] = 0u;
    LAS float* lnp = (LAS float*)(lds + CONV_SCR6);
    { const float* src = tid < 256 ? g0 : b0; const float* src1 = tid < 256 ? g : b; const int c4 = (tid & 255) * 4;
      *(LAS f32x4*)(lnp + (tid >> 8) * 1024 + c4) = *(const f32x4*)(src + c4); *(LAS f32x4*)(lnp + 2048 + (tid >> 8) * 1024 + c4) = *(const f32x4*)(src1 + c4); }
    const int fr = lane & 15, fq = lane >> 4; (void)half; (void)d0;
    bf16x8 bh[4][2], bl[4][2];
#pragma unroll
    for (int sx = 0; sx < 4; ++sx)
#pragma unroll
        for (int nt = 0; nt < 2; ++nt) { const float* wp = wr + (size_t)(wave * 128 + 32 * sx + 8 * fq) * NE + nt * 16 + fr;
            const f32x4 w0 = {wp[0], wp[NE], wp[2 * NE], wp[3 * NE]}, w1 = {wp[4 * NE], wp[5 * NE], wp[6 * NE], wp[7 * NE]};
            split8(w0, w1, bh[sx][nt], bl[sx][nt]); }
    __syncthreads();
    uint2 vy[2][4];
    LAS unsigned char* astg = lds + 98304 + wave * 4096;
#define P5_ATT_DMA(row_) do { _Pragma("unroll") for (int rr_ = 0; rr_ < 2; ++rr_) _Pragma("unroll") for (int q_ = 0; q_ < 2; ++q_) \
        __builtin_amdgcn_global_load_lds((const unsigned*)((const char*)(att + (size_t)((row_) + rr_) * D) + q_ * 1024 + lane * 16), (LAS unsigned*)(astg + rr_ * 2048 + q_ * 1024), 16, 0, 0); } while (0)
#pragma unroll
    for (int rr = 0; rr < 2; ++rr) { const size_t ro = (size_t)(rowbase + 2 * wave + rr) * D; const uint2* yr = (const uint2*)(xnb + ro) + lane;
#pragma unroll
        for (int j = 0; j < 4; ++j) vy[rr][j] = yr[64 * j]; }
    P5_ATT_DMA(rowbase + 2 * wave);
#pragma unroll 1
    for (int pass = 0; pass < 8; ++pass) {
        asm volatile("s_waitcnt vmcnt(0)" ::: "memory");
#pragma unroll
        for (int rr = 0; rr < 2; ++rr) {
            const int r = 2 * wave + rr, row = rowbase + pass * 16 + r;
            float4 v[4]; float s = 0.f;
            int lx = lane; asm volatile("" : "+v"(lx));
#pragma unroll
            for (int j = 0; j < 4; ++j) { const uint2 xw = vy[rr][j]; const u32x2 aw_ = *(const LAS u32x2*)(astg + rr * 2048 + (lx + 64 * j) * 8); uint2 aw; aw.x = aw_[0]; aw.y = aw_[1];
                v[j].x = fmaf(bflo(xw.x), ALPHA, bflo(aw.x)); v[j].y = fmaf(bfhi(xw.x), ALPHA, bfhi(aw.x)); v[j].z = fmaf(bflo(xw.y), ALPHA, bflo(aw.y)); v[j].w = fmaf(bfhi(xw.y), ALPHA, bfhi(aw.y));
                s += (v[j].x + v[j].y) + (v[j].z + v[j].w); }
            const float mean = wave_sum(s) * (1.f / D); float s2 = 0.f;
#pragma unroll
            for (int j = 0; j < 4; ++j) { v[j].x -= mean; v[j].y -= mean; v[j].z -= mean; v[j].w -= mean; s2 += (v[j].x * v[j].x + v[j].y * v[j].y) + (v[j].z * v[j].z + v[j].w * v[j].w); }
            const float rstd = rsqrtf(wave_sum(s2) * (1.f / D) + LN_EPS);
            if (lane == 0) GST(f32x2, st1 + row) = (f32x2){mean, rstd};
#pragma unroll
            for (int j = 0; j < 4; ++j) {
                const int c = (lx + 64 * j) * 4; const f32x4 gg = *(const LAS f32x4*)(lnp + 2048 + c), bb = *(const LAS f32x4*)(lnp + 3072 + c);
                float4 h; h.x = v[j].x * rstd * gg.x + bb.x; h.y = v[j].y * rstd * gg.y + bb.y; h.z = v[j].z * rstd * gg.z + bb.z; h.w = v[j].w * rstd * gg.w + bb.w;
                *(LAS f32x4*)(hs + r * D + c) = (f32x4){h.x, h.y, h.z, h.w};
                { const unsigned w0 = pack4_fp8(h.x, h.y, h.z, h.w); const unsigned w1 = (unsigned)__builtin_amdgcn_update_dpp(0, (int)w0, 0x55, 0xf, 0xf, true), w2 = (unsigned)__builtin_amdgcn_update_dpp(0, (int)w0, 0xAA, 0xf, 0xf, true), w3 = (unsigned)__builtin_amdgcn_update_dpp(0, (int)w0, 0xFF, 0xf, 0xf, true);
                  if ((lane & 3) == 0) GST(u32x4, h1f8 + (size_t)row * D + c) = (u32x4){w0, w1, w2, w3}; }
            }
        }
        if (pass < 7) {
#pragma unroll
            for (int rr = 0; rr < 2; ++rr) { const size_t ro = (size_t)(rowbase + (pass + 1) * 16 + 2 * wave + rr) * D; const uint2* yn = (const uint2*)(xnb + ro) + lane;
#pragma unroll
                for (int j = 0; j < 4; ++j) vy[rr][j] = yn[64 * j]; }
            asm volatile("s_waitcnt lgkmcnt(0)" ::: "memory");
            P5_ATT_DMA(rowbase + (pass + 1) * 16 + 2 * wave); }
        __syncthreads();
        {
            f32x4 ac0 = {0.f, 0.f, 0.f, 0.f}, ac1 = {0.f, 0.f, 0.f, 0.f};
#pragma unroll
            for (int sx = 0; sx < 4; ++sx) { const LAS float* hp = hs + fr * D + wave * 128 + 32 * sx + 8 * fq;
                bf16x8 ah, al; split8(*(const LAS f32x4*)hp, *(const LAS f32x4*)(hp + 4), ah, al);
                ac0 = __builtin_amdgcn_mfma_f32_16x16x32_bf16(ah, bh[sx][0], ac0, 0, 0, 0); ac1 = __builtin_amdgcn_mfma_f32_16x16x32_bf16(ah, bh[sx][1], ac1, 0, 0, 0);
                ac0 = __builtin_amdgcn_mfma_f32_16x16x32_bf16(ah, bl[sx][0], ac0, 0, 0, 0); ac1 = __builtin_amdgcn_mfma_f32_16x16x32_bf16(ah, bl[sx][1], ac1, 0, 0, 0);
                ac0 = __builtin_amdgcn_mfma_f32_16x16x32_bf16(al, bh[sx][0], ac0, 0, 0, 0); ac1 = __builtin_amdgcn_mfma_f32_16x16x32_bf16(al, bh[sx][1], ac1, 0, 0, 0); }
#pragma unroll
            for (int q = 0; q < 4; ++q) { part[(wave * 16 + 4 * fq + q) * 32 + fr] = ac0[q]; part[(wave * 16 + 4 * fq + q) * 32 + 16 + fr] = ac1[q]; }
        }
        __syncthreads();
        {
            const int r = tid >> 5; float lg = br[e];
#pragma unroll
            for (int w = 0; w < 8; ++w) lg += part[(w * 16 + r) * 32 + e];
            float val = lg; float tv[4]; int tix[4];
#pragma unroll
            for (int k = 0; k < 4; ++k) {
                float bv = val; int bi = e;
#pragma unroll
#define P5_AM(ov_, oi_) do { const float ov = (ov_); const int oi = (oi_); if (ov > bv || (ov == bv && oi < bi)) { bv = ov; bi = oi; } } while (0)
#define P5_AM_DPP(ctrl_) P5_AM(__int_as_float(__builtin_amdgcn_update_dpp(0, __float_as_int(bv), ctrl_, 0xf, 0xf, true)), __builtin_amdgcn_update_dpp(0, bi, ctrl_, 0xf, 0xf, true))
                P5_AM_DPP(0xB1); P5_AM_DPP(0x4E); P5_AM_DPP(0x141); P5_AM_DPP(0x140);
                { const auto rv = __builtin_amdgcn_permlane16_swap(__float_as_uint(bv), __float_as_uint(bv), false, false); const auto ri = __builtin_amdgcn_permlane16_swap((unsigned)bi, (unsigned)bi, false, false);
                  P5_AM(__uint_as_float(rv[0]), (int)ri[0]); P5_AM(__uint_as_float(rv[1]), (int)ri[1]); }
#undef P5_AM_DPP
#undef P5_AM
                tv[k] = bv; tix[k] = bi; if (e == bi) val = -INFINITY;
            }
            const float e1 = __expf(tv[1] - tv[0]), e2 = __expf(tv[2] - tv[0]), e3 = __expf(tv[3] - tv[0]); const float inv = 1.f / (1.f + e1 + e2 + e3);
            if (e < 4) { const int k = e; const int ek = k == 0 ? tix[0] : k == 1 ? tix[1] : k == 2 ? tix[2] : tix[3]; const float wk = (k == 0 ? 1.f : k == 1 ? e1 : k == 2 ? e2 : e3) * inv;
                const unsigned pl = __hip_atomic_fetch_add(hist + ek, 1u, __ATOMIC_RELAXED, __HIP_MEMORY_SCOPE_WORKGROUP); const int sidx = (pass * 16 + r) * 4 + k; sle[sidx] = (unsigned short)ek; slp[sidx] = (unsigned short)pl; slw[sidx] = wk; }
        }
    }
    __syncthreads();
    if (tid < 32) basep[tid] = __hip_atomic_fetch_add(cnt + tid, hist[tid], __ATOMIC_RELAXED, __HIP_MEMORY_SCOPE_AGENT);
    __syncthreads();
    { const int ek = sle[tid]; const size_t li = (size_t)ek * LCAP + basep[ek] + slp[tid]; GST(int, list + li) = rowbase * 4 + tid; GST(float, listw + li) = slw[tid]; }
    __syncthreads();
#undef P5_ATT_DMA
}
struct P8Par { const float* x; const float2* st0; const float2* st1; const bf16_t* att; const float* g0; const float* b0; const float* g1; const float* b1; const float* g2; const float* b2; };
struct P8Row { uint2 av[4], xv[4]; int sq[4][4]; float2 s1; };
__device__ __forceinline__ void p8_load(P8Row& R, const char* xb0, const char* ab0, const char* sb0, const float2* st1, int row, unsigned lo8, unsigned lo4) {
    const char* xb = xb0 + (size_t)row * (D * 2); const char* ab = ab0 + (size_t)row * (D * 2); const char* sb = sb0 + (size_t)row * (4 * D);
    R.s1 = st1[row];
#pragma unroll
    for (int j = 0; j < 4; ++j) { const u32x2 a2 = GLD_NT(u32x2, ab + lo8 + j * 512), x2 = GLD_NT(u32x2, xb + lo8 + j * 512); R.av[j].x = a2[0]; R.av[j].y = a2[1]; R.xv[j].x = x2[0]; R.xv[j].y = x2[1];
#pragma unroll
        for (int k = 0; k < 4; ++k) R.sq[j][k] = GLD_NT(int, sb + lo4 + k * D + j * 256); }
}
__device__ __forceinline__ void p8_compute(const P8Row& R, float* out, const LAS float* lnp, int row, unsigned lx) {
    float4 v[4]; char* ob = (char*)out + (size_t)row * (D * 4); float s = 0.f;
#pragma unroll
    for (int j = 0; j < 4; ++j) { const unsigned c = lx + j * 1024;
        { const uint2 xw = R.xv[j]; const uint2 aw = R.av[j];
          v[j].x = fmaf(bflo(xw.x), ALPHA, bflo(aw.x)); v[j].y = fmaf(bfhi(xw.x), ALPHA, bfhi(aw.x)); v[j].z = fmaf(bflo(xw.y), ALPHA, bflo(aw.y)); v[j].w = fmaf(bfhi(xw.y), ALPHA, bfhi(aw.y)); }
        { const f32x4 gg = *(const LAS f32x4*)((const LAS char*)lnp + c), bb = *(const LAS f32x4*)((const LAS char*)lnp + 4096 + c);
          v[j].x = ((v[j].x - R.s1.x) * R.s1.y * gg[0] + bb[0]) * ALPHA; v[j].y = ((v[j].y - R.s1.x) * R.s1.y * gg[1] + bb[1]) * ALPHA;
          v[j].z = ((v[j].z - R.s1.x) * R.s1.y * gg[2] + bb[2]) * ALPHA; v[j].w = ((v[j].w - R.s1.x) * R.s1.y * gg[3] + bb[3]) * ALPHA; }
#pragma unroll
        for (int k = 0; k < 4; ++k) { const f32x2 lo = __builtin_amdgcn_cvt_pk_f32_fp8(R.sq[j][k], false), hi = __builtin_amdgcn_cvt_pk_f32_fp8(R.sq[j][k], true);
            v[j].x = fmaf(lo[0], S8SI, v[j].x); v[j].y = fmaf(lo[1], S8SI, v[j].y); v[j].z = fmaf(hi[0], S8SI, v[j].z); v[j].w = fmaf(hi[1], S8SI, v[j].w); }
        s += (v[j].x + v[j].y) + (v[j].z + v[j].w); }
    const float mean = wave_sum(s) * (1.f / D); float s2 = 0.f;
#pragma unroll
    for (int j = 0; j < 4; ++j) { v[j].x -= mean; v[j].y -= mean; v[j].z -= mean; v[j].w -= mean; s2 += (v[j].x * v[j].x + v[j].y * v[j].y) + (v[j].z * v[j].z + v[j].w * v[j].w); }
    const float rstd = rsqrtf(wave_sum(s2) * (1.f / D) + LN_EPS);
#pragma unroll
    for (int j = 0; j < 4; ++j) {
        const unsigned c = lx + j * 1024; const f32x4 gg = *(const LAS f32x4*)((const LAS char*)lnp + 8192 + c), bb = *(const LAS f32x4*)((const LAS char*)lnp + 12288 + c);
        GST_NT(f32x4, ob + c, ((f32x4){v[j].x * rstd * gg[0] + bb[0], v[j].y * rstd * gg[1] + bb[1], v[j].z * rstd * gg[2] + bb[2], v[j].w * rstd * gg[3] + bb[3]}));
    }
}
__device__ __forceinline__ void p8_stream(float* out, const bf16_t* slot, const P8Par& P, const LAS float* lnp, int row0, int stride, int lane) {
    const unsigned lo16 = (unsigned)lane * 16u, lo8 = (unsigned)lane * 8u, lo4 = (unsigned)lane * 4u;
    const char* xb0 = (const char*)P.x; const char* ab0 = (const char*)P.att; const char* sb0 = (const char*)slot;
    P8Row A, B; int row = row0; if (row >= NTOK) return;
    p8_load(A, xb0, ab0, sb0, P.st1, row, lo8, lo4);
    for (;;) {
        asm volatile("" : "+s"(xb0), "+s"(ab0), "+s"(sb0));
        unsigned lx = lo16; asm volatile("" : "+v"(lx));
        const int r1 = row + stride; const bool h1 = r1 < NTOK; if (h1) p8_load(B, xb0, ab0, sb0, P.st1, r1, lo8, lo4);
        p8_compute(A, out, lnp, row, lx); if (!h1) break;
        const int r2 = r1 + stride; const bool h2 = r2 < NTOK; if (h2) p8_load(A, xb0, ab0, sb0, P.st1, r2, lo8, lo4);
        p8_compute(B, out, lnp, r1, lx); if (!h2) break;
        row = r2;
    }
}

#define PH_LOCALS \
    int tid = threadIdx.x; asm volatile("" : "+v"(tid)); const int lane = tid & 63, wave = __builtin_amdgcn_readfirstlane(tid >> 6); (void)lane; (void)wave; \
    unsigned char* ws = args.ws; asm volatile("" : "+s"(ws)); \
    const float* x = args.in[0]; (void)x; \
    bf16_t* xn = (bf16_t*)(ws + WS_XN); bf16_t* proj = (bf16_t*)(ws + WS_PROJ); (void)xn; (void)proj; \
    bf16_t* win_t = (bf16_t*)(ws + WS_WIN); bf16_t* wa_t = (bf16_t*)(ws + WS_WA); bf16_t* wb_t = (bf16_t*)(ws + WS_WB); bf16_t* wout_t = (bf16_t*)(ws + WS_WOUT); (void)win_t; (void)wa_t; (void)wb_t; (void)wout_t; \
    bf16_t* wei_t = (bf16_t*)(ws + WS_WEI); bf16_t* weo_t = (bf16_t*)(ws + WS_WEO); (void)wei_t; (void)weo_t; \
    bf16_t* outab = (bf16_t*)(ws + WS_OUTAB); bf16_t* merged = (bf16_t*)(ws + WS_MERGED); bf16_t* slotb = (bf16_t*)(ws + WS_SLOT); bf16_t* abuf = proj; bf16_t* h1b = xn; (void)outab; (void)merged; (void)slotb; (void)abuf; (void)h1b; \
    int* topi = (int*)(ws + WS_TOPI); float* topw = (float*)(ws + WS_TOPW); int* list = (int*)(ws + WS_LIST); (void)topi; (void)topw; (void)list; \
    gu32* ctl = (gu32*)(ws + WS_CTL); (void)ctl; \
    LAS int* tt = (LAS int*)(lds + TTAB_OFF); LAS unsigned* toktab = (LAS unsigned*)(lds + TOKTAB_OFF); (void)tt; (void)toktab;

__global__ void __launch_bounds__(NWAVES * 64, 2) mega(Args args) {
    extern __shared__ __attribute__((aligned(16))) unsigned char lds_raw[];
    LAS unsigned char* lds = (LAS unsigned char*)lds_raw;
    volatile LAS unsigned* MISC = (volatile LAS unsigned*)(lds + MISC_OFF);
    const int tid = threadIdx.x, lane = tid & 63, wave = __builtin_amdgcn_readfirstlane(tid >> 6);
    const int G = gridDim.x; const int bx = blockIdx.x; const int vcu = (G % 8 == 0) ? (bx % 8) * (G / 8) + bx / 8 : bx;
    unsigned char* ws = args.ws;
    gu32* ctl = (gu32*)(ws + WS_CTL);
    if (tid < 64) MISC[tid] = 0u;
    __syncthreads();
    XcdBarrier bar = xcd_barrier_post((unsigned*)ctl + CW_BAR + args.li * XCD_BAR_WORDS, MISC + 8);
    const int lo = args.ph_lo, hi = args.ph_hi;
#ifndef PHMASK
#define PHMASK 0x1ff
#endif
#define IN(k) (((PHMASK >> (k)) & 1) && lo <= (k) && (k) < hi)
#define BOTH(k) (IN(k) && IN((k) + 1))

#if PROBE_PH == 0
    for (int rep_ = 0; rep_ < 2; ++rep_)
#endif
    if (IN(0)) {
        PH_LOCALS
        LAS float* scr = (LAS float*)(lds + RING_OFF + wave * 16640);
        constexpr int I_IN = 16 * 80, I_A = 8 * 16, I_OUT = 16 * 16, I_EI = 16 * 32, I_EO = 16 * 16;
        constexpr int NITEMS = I_IN + 2 * I_A + I_OUT;
#define P0_DECODE(it_, sub_, I) do { int r = (it_); \
            if (r < I_IN / 2) { const int kb = 2 * (r / 80) + (sub_), nb = r % 80; I.W = args.in[3]; I.N = INC; I.K = D; I.k0 = 64 * kb; I.n0 = 64 * nb; \
                if (nb < 48) { I.WT = (unsigned char*)win_t; I.rowbase = 64 * nb; I.f8 = 0; } else { I.WT = (unsigned char*)win_t + (size_t)3072 * D * 2; I.rowbase = 64 * nb - 3072; I.f8 = 1; } break; } r -= I_IN / 2; \
            if (r < I_A / 2) { const int kb = 2 * (r / 16) + (sub_), nb = r % 16; I.W = args.in[11]; I.N = D; I.K = 512; I.k0 = 64 * kb; I.n0 = 64 * nb; I.WT = (unsigned char*)wa_t; I.rowbase = 64 * nb; I.f8 = 1; break; } r -= I_A / 2; \
            if (r < I_A / 2) { const int kb = 2 * (r / 16) + (sub_), nb = r % 16; I.W = args.in[12]; I.N = D; I.K = 512; I.k0 = 64 * kb; I.n0 = 64 * nb; I.WT = (unsigned char*)wb_t; I.rowbase = 64 * nb; I.f8 = 1; break; } r -= I_A / 2; \
            if (r < I_OUT / 2) { const int kb = 2 * (r / 16) + (sub_), nb = r % 16; I.W = args.in[13]; I.N = D; I.K = D; I.k0 = 64 * kb; I.n0 = 64 * nb; I.WT = (unsigned char*)wout_t; I.rowbase = 64 * nb; I.f8 = 1; break; } r -= I_OUT / 2; \
            { I.W = args.in[13]; I.N = D; I.K = D; I.k0 = 0; I.n0 = 0; I.WT = (unsigned char*)wout_t; I.rowbase = 0; I.f8 = 1; } } while (0)
        { P0Item ia, ib; f32x4 va[16], vb[16]; int it = vcu + G * wave; constexpr int NSUP = NITEMS / 2; const int NGW = G * NWAVES;
          if (it < NSUP) { P0_DECODE(it, 0, ia); p0_load(ia, va, lane); }
          while (it < NSUP) {
              P0_DECODE(it, 1, ib); p0_load(ib, vb, lane);
              p0_proc(ia, va, scr, lane);
              const bool hn_ = (it + NGW) < NSUP;
              if (hn_) { P0_DECODE(it + NGW, 0, ia); p0_load(ia, va, lane); }
              p0_proc(ib, vb, scr, lane);
              it += NGW;
          } }
#undef P0_DECODE
        for (;;) { unsigned bch = 0u; if (lane == 0) bch = __hip_atomic_fetch_add((LAS unsigned*)(lds + MISC_OFF) + 32, 1u, __ATOMIC_RELAXED, __HIP_MEMORY_SCOPE_WORKGROUP); bch = (unsigned)__builtin_amdgcn_readfirstlane((int)bch);
            const int blk = vcu + (int)(bch >> 5) * G; if (blk >= NTOK / 128) break;
            ln_rows_in<4>(x, args.in[1], args.in[2], xn, (unsigned char*)merged  , blk * 128 + (int)(bch & 31u) * 4, 1, lane); }
        { u32x4* lz = (u32x4*)(ws + WS_LIST); const u32x4 z = {0u, 0u, 0u, 0u}; for (int i = bx * 512 + tid; i < (int)(NE * LCAP * 4 / 16); i += G * 512) GST(u32x4, lz + i) = z; }
        if (BOTH(0)) xcd_barrier(bar);
    }
#if PROBE_PH == 1
    for (int rep_ = 0; rep_ < 2; ++rep_)
#endif
    if (IN(1)) {
        PH_LOCALS
        { SchedDense S; S.go.init(NTOK / 256, 12, G, bx); S.A = (const char*)xn; S.B = (const char*)win_t; S.tstepA = (size_t)256 * D * 2; S.tstepB = (size_t)256 * D * 2; S.pn_off = 0;
          EpiProj E{proj, (int*)(ctl + CW_NRM), ws + WS_VBLK, ws + WS_KBLK};
          pg::gemm_phase<EpiProj, SchedDense, false>(lds + RING_OFF, nullptr, nullptr, D, D * 2, D * 2, S, E, ws); }
        { SchedDense S; S.go.init(NTOK / 256, 8, G, bx); S.A = (const char*)merged; S.B = (const char*)win_t + (size_t)3072 * D * 2; S.tstepA = (size_t)256 * D; S.tstepB = (size_t)256 * D; S.pn_off = 12;
          EpiGates E{ws + WS_GATES, args.in[4], W8SI};
          pg::gemm_phase<EpiGates, SchedDense, false, true>(lds + RING_OFF, nullptr, nullptr, D / 2, D, D, S, E, ws); }
        if (BOTH(1)) xcd_barrier(bar);
    }
#if PROBE_PH == 2
    for (int rep_ = 0; rep_ < 2; ++rep_)
#endif
    if (IN(2)) {
        PH_LOCALS
        bf16_t* outab_ = outab; float* oc0 = (float*)(ws + WS_SLOT);
        { LAS float* bt = (LAS float*)(lds + att::L_TAB); const float* relb = args.in[10]; for (int i = tid; i < 8 * 256; i += NWAVES * 64) { const int d_ = (i & 255) - 192; bt[i] = relb[(i >> 8) * 257 + min(max(d_, -128), 128) + 128] * LOG2E; } }
        if (wave == 0) { for (int hh = 0; hh < 8; ++hh) { float m_ = -1e30f; for (int i = lane; i < 257; i += 64) m_ = fmaxf(m_, args.in[10][hh * 257 + i] * LOG2E); m_ = wave_max(m_); if (lane == 0) ((LAS float*)(lds + 100864))[8 + hh] = m_ + 1e-6f; } }
        { const float lam_ = __expf(wave_sum(args.in[5][lane] * args.in[6][lane])) - __expf(wave_sum(args.in[7][lane] * args.in[8][lane])) + LAM_INIT; if (tid == 0) ((LAS float*)(lds + 100864))[3] = lam_; }
        __syncthreads();
        const int* nrmsq = (const int*)(ctl + CW_NRM);
#define NRM(i) (sqrtf(2.f * __uint_as_float((unsigned)nrmsq[(i)])) * 1.01f)
        constexpr int C_EI = 16 * 32 / 2, C_EO = 16 * 16 / 2, C_PER_WG = (NE * (C_EI + C_EO) + 255) / 256;
        bool cdone = false;
#define CONV_DECODE(si_, sub_, I) do { int r = (si_); \
            if (r < NE * C_EI) { const int e = r / C_EI, q = r % C_EI, kb = 2 * (q / 32) + (sub_), nb = q % 32; const int n0 = 64 * nb, j0 = n0 & 1023;     \
                I.W = args.in[18] + (size_t)e * D * 2 * DFF; I.N = 2 * DFF; I.K = D; I.k0 = 64 * kb; I.n0 = n0; I.WT = (unsigned char*)wei_t + (size_t)e * 2 * DFF * D; I.rowbase = 256 * (j0 >> 7) + (n0 >= 1024 ? 128 : 0) + (j0 & 127); I.f8 = 1; break; } r -= NE * C_EI; \
            { const int e = r / C_EO, q = r % C_EO, kb = 2 * (q / 16) + (sub_), nb = q % 16; I.W = args.in[20] + (size_t)e * DFF * D; I.N = D; I.K = DFF; I.k0 = 64 * kb; I.n0 = 64 * nb; I.WT = (unsigned char*)weo_t + (size_t)e * D * DFF; I.rowbase = 64 * nb; I.f8 = 1; } } while (0)
#define CONV_ROUNDS(nr_) do { int tc_ = threadIdx.x; asm volatile("" : "+v"(tc_)); const int lc_ = tc_ & 63, wc_ = __builtin_amdgcn_readfirstlane(tc_ >> 6); \
        for (int rr_ = 0; rr_ < (nr_) && !cdone; ++rr_) { \
            if (tc_ == 0) qbox[5] = (int)__hip_atomic_fetch_add(ctl + CW_CQ, 7u, __ATOMIC_RELAXED, __HIP_MEMORY_SCOPE_AGENT); \
            __syncthreads(); const int sb_ = __builtin_amdgcn_readfirstlane(qbox[5]); __syncthreads(); \
            if (sb_ >= NE * (C_EI + C_EO)) { cdone = true; break; } \
            const int si_ = sb_ + wc_; \
            if (wc_ < 7 && si_ < NE * (C_EI + C_EO)) { P0Item ia_, ib_; f32x4 va_[16], vb_[16]; LAS float* scr_ = (LAS float*)(lds + (wc_ < 5 ? wc_ * 16640 : (wc_ == 5 ? 102400 : CONV_SCR6))); \
                CONV_DECODE(si_, 0, ia_); p0_load(ia_, va_, lc_); CONV_DECODE(si_, 1, ib_); p0_load(ib_, vb_, lc_); p0_proc(ia_, va_, scr_, lc_); p0_proc(ib_, vb_, scr_, lc_); } } } while (0)
        LAS int* order = (LAS int*)(lds + 101376);
        LAS int* qbox = (LAS int*)(lds + 100864);
        const int x0 = (G % 8 == 0) ? (bx % 8) : 0;
        for (int kx = 0; kx < 8; ++kx) {
            const int x = (x0 + kx) & 7; const int bq = x >> 1, hA = 2 + (x & 1), hB = (x & 1) ? 0 : 1;
            __syncthreads();
            constexpr int SQ = ATT_SPLIT_QB, NEA = SQ + 2 * (32 - SQ), NENT = NEA + 32;
#define ENT_COST(e, out) do { const int e_ = (e); if (e_ < SQ) out = 2 * (4 * e_ + 4); else if (e_ < NEA) out = 4 * (SQ + ((e_ - SQ) >> 1)) + 4; else { const int capB = hB == 0 ? 16 : 44; out = 2 * min(4 * (e_ - NEA) + 4, capB); } } while (0)
            if (tid < NENT) { int cu; ENT_COST(tid, cu); int rank = 0;
                for (int v = 0; v < NENT; ++v) { int cv; ENT_COST(v, cv); rank += (cv > cu || (cv == cu && v < tid)) ? 1 : 0; }
                order[rank] = tid; }
#undef ENT_COST
            __syncthreads();
            for (;;) {
                { int t0 = threadIdx.x; asm volatile("" : "+v"(t0)); if (t0 == 0) qbox[0] = (int)__hip_atomic_fetch_add(ctl + CW_Q + 64 * x, 1u, __ATOMIC_RELAXED, __HIP_MEMORY_SCOPE_AGENT); }
                __syncthreads();
                const int qi = __builtin_amdgcn_readfirstlane(qbox[0]);
                if (qi >= NENT + 128) break;
                if (qi < NENT) {
                    const int e = __builtin_amdgcn_readfirstlane(order[qi]); const int b_ = bq;
                    const int h_ = e < NEA ? hA : hB, qb_ = e < SQ ? e : (e < NEA ? SQ + ((e - SQ) >> 1) : e - NEA), cm = (e >= SQ && e < NEA) ? ((e - SQ) & 1) : 2;
                    int tq = threadIdx.x; asm volatile("" : "+v"(tq));
                    if (tq < 2) qbox[1 + tq] = 4 * qb_;
                    __syncthreads();
                    if (tq < 256) { const int c_ = tq >> 7, t = tq & 127; const int bhc = (b_ * 4 + h_) * 2 + c_; const int kn = bhc * 128, qn = (32 + bhc) * 128;
                        const float slope2 = exp2f(-2.f * (float)(h_ + 1)) * LOG2E;
                        const float qmax = fmaxf(fmaxf(NRM(qn + 4 * qb_), NRM(qn + 4 * qb_ + 1)), fmaxf(NRM(qn + 4 * qb_ + 2), NRM(qn + 4 * qb_ + 3)));
                        if (t < 4 * qb_) { const float bound = qmax * NRM(kn + t) - slope2 * (float)(qb_ * 256 - 64 * t - 63);
                            if (!(bound < -152.f)) __hip_atomic_fetch_min(qbox + 1 + c_, t, __ATOMIC_RELAXED, __HIP_MEMORY_SCOPE_WORKGROUP); } }
                    __syncthreads();
                    const int tlo0 = __builtin_amdgcn_readfirstlane(qbox[1]), tlo1 = __builtin_amdgcn_readfirstlane(qbox[2]);
                    if (tq < 2) qbox[6 + tq] = 0;
                    __syncthreads();
                    if (tq < 256) { const int c_ = tq >> 7, t = tq & 127; const int bhc = (b_ * 4 + h_) * 2 + c_; const int tl_ = c_ ? tlo1 : tlo0;
                        if (t >= tl_ && t <= 4 * qb_ + 3) __hip_atomic_fetch_max(qbox + 6 + c_, (int)__float_as_uint(NRM(bhc * 128 + t)), __ATOMIC_RELAXED, __HIP_MEMORY_SCOPE_WORKGROUP); }
                    __syncthreads();
                    const float kmax0 = __uint_as_float((unsigned)__builtin_amdgcn_readfirstlane(qbox[6])), kmax1 = __uint_as_float((unsigned)__builtin_amdgcn_readfirstlane(qbox[7]));
                    const float lam = __builtin_bit_cast(float, __builtin_amdgcn_readfirstlane(qbox[3]));
#if PROBE_PH == 23
                    for (int rep_ = 0; rep_ < 2; ++rep_)
#endif
                    att::unit_a(lds + RING_OFF, proj, oc0, outab_, args.in[9], lam, ctl + CW_AC, qbox, b_, h_, cm, qb_, tlo0, tlo1, kmax0, kmax1);
                } else {
                    const int u = qi - NENT; const int bh = 4 * x + (u & 3), qb_ = 31 - (u >> 2);
                    { int tq = threadIdx.x; asm volatile("" : "+v"(tq)); if (tq == 0) qbox[6] = 0; __syncthreads();
                      const int tl_ = 4 * qb_ - 8 < 0 ? 0 : 4 * qb_ - 8;
                      if (tq < 128 && tq >= tl_ && tq <= 4 * qb_ + 3) __hip_atomic_fetch_max(qbox + 6, (int)__float_as_uint(NRM((64 + bh) * 128 + tq)), __ATOMIC_RELAXED, __HIP_MEMORY_SCOPE_WORKGROUP);
                      __syncthreads(); }
#if PROBE_PH == 24
                    for (int rep_ = 0; rep_ < 2; ++rep_)
#endif
                    att::unit_b(lds + RING_OFF, proj, outab_, bh >> 3, bh & 7, qb_, __uint_as_float((unsigned)__builtin_amdgcn_readfirstlane(qbox[6])), __builtin_bit_cast(float, __builtin_amdgcn_readfirstlane(qbox[8 + (bh & 7)])));
                }
                __syncthreads();
                CONV_ROUNDS(2);
            }
        }
        __syncthreads();
        CONV_ROUNDS(1 << 20);
        asm volatile("s_waitcnt vmcnt(0)" ::: "memory");
#undef CONV_ROUNDS
#undef CONV_DECODE
#undef NRM
        if (BOTH(2)) xcd_barrier(bar);
    }
#if PROBE_PH == 3
    for (int rep_ = 0; rep_ < 2; ++rep_)
#endif
    if (IN(3)) {
        PH_LOCALS
        SchedMerged S; S.go.init(NTOK / 256, D / 256, G, bx); S.outab = (const char*)outab; S.wa = (const char*)wa_t; S.wb = (const char*)wb_t;
        EpiMerged E{ws + WS_GATES, merged};
        pg::gemm_phase<EpiMerged, SchedMerged, false, true>(lds + RING_OFF, nullptr, nullptr, 256, D, 512, S, E, ws);
        if (BOTH(3)) xcd_barrier(bar);
    }
#if PROBE_PH == 4
    for (int rep_ = 0; rep_ < 2; ++rep_)
#endif
    if (IN(4)) {
        PH_LOCALS
        SchedDense S; S.go.init(NTOK / 256, D / 256, G, bx); S.A = (const char*)merged; S.B = (const char*)wout_t; S.tstepA = (size_t)256 * D; S.tstepB = (size_t)256 * D; S.pn_off = 0;
        EpiY E{outab  };
        pg::gemm_phase<EpiY, SchedDense, false, true>(lds + RING_OFF, nullptr, nullptr, D / 2, D, D, S, E, ws);
        if (BOTH(4)) xcd_barrier(bar);
    }
    if (IN(5)) {
        PH_LOCALS
        for (int rb = bx * 128; rb < NTOK; rb += G * 128) p5_router(lds + RING_OFF, xn, args.in[1], args.in[2], outab, (float2*)(ws + WS_ST1), args.in[14], args.in[15], args.in[16], args.in[17], h1b, (unsigned char*)merged, topi, topw, ctl + CW_CNT, list, (float*)(ws + WS_WA)  , rb, tid, lane, wave);
        if (BOTH(5)) xcd_barrier(bar);
    }
#if PROBE_PH == 6
    for (int rep_ = 0; rep_ < 2; ++rep_)
#endif
    if (IN(6)) {
        PH_LOCALS
        build_tile_table(tt, ctl + CW_CNT, tid);
        const int ntl = __builtin_amdgcn_readfirstlane(tt[2 * MAXT + 32]);
        SchedExpert S; S.go.init(ntl, 8, G, bx); S.tt = tt; S.A = (const char*)merged  ; S.B = (const char*)wei_t; S.bstride_e = (size_t)2 * DFF * D; S.bstride_n = (size_t)256 * D; S.astride_t = 0; S.gatherA = true;
        EpiSwiglu E{args.in[19], abuf};
        pg::gemm_phase<EpiSwiglu, SchedExpert, true, true>(lds + RING_OFF, toktab, list, D / 2, D, D, S, E, ws);
        if (BOTH(6)) xcd_barrier(bar);
    }
#if PROBE_PH == 7
    for (int rep_ = 0; rep_ < 2; ++rep_)
#endif
    if (IN(7)) {
        PH_LOCALS
        if (!IN(6)) build_tile_table(tt, ctl + CW_CNT, tid);
        const int ntl = __builtin_amdgcn_readfirstlane(tt[2 * MAXT + 32]);
        SchedExpert S; S.go.init(ntl, 4, G, bx); S.tt = tt; S.A = (const char*)abuf; S.B = (const char*)weo_t; S.bstride_e = (size_t)D * DFF; S.bstride_n = (size_t)256 * DFF; S.astride_t = (size_t)256 * DFF; S.gatherA = false;
        EpiScatter E{args.in[21], (const float*)(ws + WS_WA), slotb};
        pg::gemm_phase<EpiScatter, SchedExpert, false, true>(lds + RING_OFF, toktab, list, DFF / 2, DFF, DFF, S, E, ws);
        if (BOTH(7)) xcd_barrier(bar);
    }
#if PROBE_PH == 8
    for (int rep_ = 0; rep_ < 2; ++rep_)
#endif
    if (IN(8)) {
        PH_LOCALS
        const int gw = vcu * NWAVES + wave, NGW = G * NWAVES;
        const P8Par PP{(const float*)xn  , (const float2*)(ws + WS_ST0), (const float2*)(ws + WS_ST1), outab, args.in[1], args.in[2], args.in[14], args.in[15], args.in[22], args.in[23]};
        { LAS float* lnp = (LAS float*)(lds + RING_OFF); const float* src = tid < 256 ? (tid < 128 ? args.in[14] : args.in[15]) : (tid < 384 ? args.in[22] : args.in[23]);
          const int a_ = tid >> 7, c8 = (tid & 127) * 8; *(LAS f32x4*)(lnp + a_ * 1024 + c8) = *(const f32x4*)(src + c8); *(LAS f32x4*)(lnp + a_ * 1024 + c8 + 4) = *(const f32x4*)(src + c8 + 4);
          __syncthreads();
          p8_stream(args.out, slotb, PP, lnp, gw, NGW, lane); }
    }
#undef IN
#undef BOTH
}


extern "C" void kernel_launch(void* const* d_in, const int* in_sizes, int n_in, void* d_out, int out_size, void* d_ws, size_t ws_size, hipStream_t stream) {
    if (n_in != 24 || ws_size < WS_END) { fprintf(stderr, "kernel_launch: unexpected n_in %d / ws %zu\n", n_in, ws_size); return; }
    static int grid = 0;
    if (grid == 0) {
        int dev = 0, cus = 0;
        if (hipGetDevice(&dev) != hipSuccess || hipDeviceGetAttribute(&cus, hipDeviceAttributeMultiprocessorCount, dev) != hipSuccess) { grid = -1; return; }
        if (hipFuncSetAttribute((const void*)mega, hipFuncAttributeMaxDynamicSharedMemorySize, LDS_BYTES) != hipSuccess) { fprintf(stderr, "kernel_launch: hipFuncSetAttribute failed\n"); grid = -1; return; }
        grid = cus;
    }
    if (grid < 0) return;
    unsigned char* ws = (unsigned char*)d_ws; float* out = (float*)d_out;
    (void)hipMemsetAsync(ws + WS_CTL, 0, 1 * MiB, stream);
    Args a{}; for (int i = 0; i < 24; ++i) a.in[i] = (const float*)d_in[i]; a.out = out; a.ws = ws;
    a.ph_lo = 0; a.ph_hi = 9; a.li = 0;
    hipLaunchKernelGGL(mega, dim3(grid), dim3(NWAVES * 64), LDS_BYTES, stream, a);
}
```
